# Optimizing an MI355X kernel written in HIP

```python
import math, functools
import jax, jax.numpy as jnp
from jax import lax
import numpy as np

D_MODEL = 1024
BATCH = 4
SEQ = 4096
DEPTH = 1

MIX_WIDTH = D_MODEL
HEAD_DIM = 64
ATTN_WIDTH = D_MODEL // 2
N_HEADS_ATTN = ATTN_WIDTH // HEAD_DIM
POOL_WIDTH = D_MODEL // 4
POOL_WINDOWS = (2, 4, 8, 16)
POOL_GROUP = POOL_WIDTH // len(POOL_WINDOWS)
MEM_WIDTH = D_MODEL // 4
MEM_HEADS = 4
MEM_HEAD_DIM = MEM_WIDTH // MEM_HEADS
N_MEM = 256
IN_WIDTH = 3 * ATTN_WIDTH + POOL_WIDTH + MEM_WIDTH

DILATED_PATTERNS = ((128, 1), (512, 4), (2048, 16))
BLOCK = 128

N_GROUPS = 8
EXPERTS_PER_GROUP = 8
N_EXPERTS = N_GROUPS * EXPERTS_PER_GROUP
TOP_K_INNER = 2
EXPERT_HIDDEN = D_MODEL // 2
ROUTE_BLOCK = 128

EPS = 1e-6
NEG_INF = -1e30

kernel_name = "hymba_dilated_pool_memory_hiermoe"


def _rms_norm(x, g):
    xf = x.astype(jnp.float32)
    y = xf * lax.rsqrt(jnp.mean(xf * xf, axis=-1, keepdims=True) + EPS)
    return (y * g.astype(jnp.float32)).astype(x.dtype)


def _banded_window_attention(q, k, v, steps):
    N, L, H, hd = q.shape
    nb = -(-L // BLOCK)
    pad = nb * BLOCK - L

    def blocks(t):
        return jnp.pad(t, ((0, 0), (0, pad), (0, 0), (0, 0))).reshape(N, nb, BLOCK, H, hd)

    def band(t):
        prev = jnp.concatenate([jnp.zeros_like(t[:, :1]), t[:, :-1]], axis=1)
        return jnp.concatenate([prev, t], axis=2)

    qb = blocks(q)
    kk = band(blocks(k))
    vv = band(blocks(v))
    s = jnp.einsum('nbqhd,nbkhd->nbhqk', qb, kk).astype(jnp.float32) * (hd ** -0.5)
    qi = jnp.arange(BLOCK)[:, None]
    kj = jnp.arange(2 * BLOCK)[None, :]
    dist = qi + BLOCK - kj
    in_band = (dist >= 0) & (dist <= steps)
    has_prev = (jnp.arange(nb) > 0)[:, None, None] | (kj >= BLOCK)[None]
    mask = in_band[None] & has_prev
    s = jnp.where(mask[None, :, None], s, NEG_INF)
    m = jnp.max(s, axis=-1, keepdims=True)
    p = jnp.exp(s - m)
    den = jnp.sum(p, axis=-1, keepdims=True)
    o = jnp.einsum('nbhqk,nbkhd->nbqhd', p, vv.astype(jnp.float32))
    o = o / jnp.transpose(den[..., 0], (0, 1, 3, 2))[..., None]
    lse = jnp.transpose((m + jnp.log(den))[..., 0], (0, 1, 3, 2))
    o = o.reshape(N, nb * BLOCK, H, hd)[:, :L]
    lse = lse.reshape(N, nb * BLOCK, H)[:, :L]
    return o, lse


def _dilated_attention_mixture(q, k, v):
    B, S, H, hd = q.shape
    outs, lses = [], []
    for window, dil in DILATED_PATTERNS:
        L = S // dil
        qr = q.reshape(B, L, dil, H, hd).transpose(0, 2, 1, 3, 4).reshape(B * dil, L, H, hd)
        kr = k.reshape(B, L, dil, H, hd).transpose(0, 2, 1, 3, 4).reshape(B * dil, L, H, hd)
        vr = v.reshape(B, L, dil, H, hd).transpose(0, 2, 1, 3, 4).reshape(B * dil, L, H, hd)
        o, lse = _banded_window_attention(qr, kr, vr, window // dil)
        outs.append(o.reshape(B, dil, L, H, hd).transpose(0, 2, 1, 3, 4).reshape(B, S, H, hd))
        lses.append(lse.reshape(B, dil, L, H).transpose(0, 2, 1, 3).reshape(B, S, H))
    alpha = jax.nn.softmax(jnp.stack(lses, axis=0), axis=0)
    return jnp.sum(alpha[..., None] * jnp.stack(outs, axis=0), axis=0)


def _multiscale_pool(u, proj, scale):
    B, S, C = u.shape
    uf = u.astype(jnp.float32)
    c0 = jnp.concatenate([jnp.zeros((B, 1, C), jnp.float32), jnp.cumsum(uf, axis=1)], axis=1)
    groups = []
    for gi, w in enumerate(POOL_WINDOWS):
        sl = slice(gi * POOL_GROUP, (gi + 1) * POOL_GROUP)
        cg = c0[:, :, sl]
        upper = cg[:, 1:]
        lower = jnp.concatenate([jnp.zeros((B, w - 1, POOL_GROUP), jnp.float32), cg[:, :S + 1 - w]], axis=1)
        cnt = jnp.minimum(jnp.arange(1, S + 1), w).astype(jnp.float32)[None, :, None]
        groups.append((upper - lower) / cnt - uf[:, :, sl])
    pooled = jnp.stack(groups, axis=2)
    y = jnp.einsum('bsgc,gce->bsge', pooled, proj.astype(jnp.float32)).reshape(B, S, C)
    return y * scale.astype(jnp.float32)


def _memory_attention(qm, mem, mem_norm, w_mem_kv, mq_norm, mk_norm):
    B, S, _ = qm.shape
    mn = _rms_norm(mem, mem_norm)
    kv = jnp.einsum('bmd,de->bme', mn, w_mem_kv)
    km = kv[..., :MEM_WIDTH].reshape(B, -1, MEM_HEADS, MEM_HEAD_DIM)
    vm = kv[..., MEM_WIDTH:].reshape(B, -1, MEM_HEADS, MEM_HEAD_DIM)
    q = _rms_norm(qm.reshape(B, S, MEM_HEADS, MEM_HEAD_DIM), mq_norm)
    km = _rms_norm(km, mk_norm)
    s = jnp.einsum('bshd,bmhd->bhsm', q, km).astype(jnp.float32) * (MEM_HEAD_DIM ** -0.5)
    p = jax.nn.softmax(s, axis=-1)
    return jnp.einsum('bhsm,bmhd->bshd', p, vm.astype(jnp.float32)).reshape(B, S, MEM_WIDTH)


def _hier_moe(h, w_group, b_group, w_router, b_router, w1, w3, w2):
    T, D = h.shape
    lg = (jnp.einsum('td,dg->tg', h, w_group) + b_group).astype(jnp.float32)
    pg = jax.nn.softmax(lg, axis=-1)
    g_sel = jnp.argmax(lg, axis=-1)
    w_g = jnp.take_along_axis(pg, g_sel[:, None], axis=-1)[:, 0]
    le = (jnp.einsum('td,gde->tge', h, w_router) + b_router).astype(jnp.float32)
    le = jnp.take_along_axis(le, g_sel[:, None, None], axis=1)[:, 0]
    top_v, top_i = lax.top_k(le, TOP_K_INNER)
    gates = w_g[:, None] * jax.nn.softmax(top_v, axis=-1)
    eid = (g_sel[:, None] * EXPERTS_PER_GROUP + top_i).reshape(-1).astype(jnp.int32)
    tok = jnp.repeat(jnp.arange(T, dtype=jnp.int32), TOP_K_INNER)
    gate = gates.reshape(-1)
    order = jnp.argsort(eid)
    eid_s, tok_s, gate_s = eid[order], tok[order], gate[order]
    counts = jnp.bincount(eid, length=N_EXPERTS)
    starts = jnp.cumsum(counts) - counts
    padded = ((counts + ROUTE_BLOCK - 1) // ROUTE_BLOCK) * ROUTE_BLOCK
    pends = jnp.cumsum(padded)
    pstarts = pends - padded
    n_assign = T * TOP_K_INNER
    rank = jnp.arange(n_assign, dtype=jnp.int32) - starts[eid_s]
    dest = pstarts[eid_s] + rank
    R = n_assign + N_EXPERTS * ROUTE_BLOCK
    n_blk = R // ROUTE_BLOCK
    row_tok = jnp.full((R,), T, jnp.int32).at[dest].set(tok_s)
    row_gate = jnp.zeros((R,), jnp.float32).at[dest].set(gate_s)
    blk_exp = jnp.minimum(jnp.searchsorted(pends, jnp.arange(n_blk) * ROUTE_BLOCK, side='right'),
                          N_EXPERTS - 1).astype(jnp.int32)
    h_pad = jnp.concatenate([h, jnp.zeros((1, D), h.dtype)], axis=0)
    xr = h_pad[row_tok].reshape(n_blk, ROUTE_BLOCK, D)

    def expert_block(args):
        xb, e = args
        a = jnp.einsum('rd,df->rf', xb, w1[e])
        b = jnp.einsum('rd,df->rf', xb, w3[e])
        return jnp.einsum('rf,fd->rd', jax.nn.silu(a) * b, w2[e])

    yb = lax.map(expert_block, (xr, blk_exp)).reshape(R, D).astype(jnp.float32)
    y = jax.ops.segment_sum(yb * row_gate[:, None], row_tok, num_segments=T + 1)[:T]
    return y


def _layer(x, mem, attn_norm, w_in, q_norm, k_norm, pool_proj, pool_scale, mem_norm, w_mem_kv,
           mq_norm, mk_norm, w_out, ffn_norm, w_group, b_group, w_router, b_router, w1, w3, w2):
    B, S, D = x.shape
    h = _rms_norm(x, attn_norm)
    z = jnp.einsum('bsd,de->bse', h, w_in)
    a0, a1, a2, a3 = ATTN_WIDTH, 2 * ATTN_WIDTH, 3 * ATTN_WIDTH, 3 * ATTN_WIDTH + POOL_WIDTH
    q = _rms_norm(z[..., :a0].reshape(B, S, N_HEADS_ATTN, HEAD_DIM), q_norm)
    k = _rms_norm(z[..., a0:a1].reshape(B, S, N_HEADS_ATTN, HEAD_DIM), k_norm)
    v = z[..., a1:a2].reshape(B, S, N_HEADS_ATTN, HEAD_DIM)
    u = z[..., a2:a3]
    qm = z[..., a3:]
    y_attn = _dilated_attention_mixture(q, k, v).reshape(B, S, ATTN_WIDTH)
    y_pool = _multiscale_pool(u, pool_proj, pool_scale)
    y_mem = _memory_attention(qm, mem, mem_norm, w_mem_kv, mq_norm, mk_norm)
    mix = jnp.concatenate([y_attn, y_pool, y_mem], axis=-1).astype(x.dtype)
    x = x + jnp.einsum('bse,ed->bsd', mix, w_out)
    h2 = _rms_norm(x, ffn_norm).reshape(B * S, D)
    y = _hier_moe(h2, w_group, b_group, w_router, b_router, w1, w3, w2)
    return x + y.reshape(B, S, D).astype(x.dtype)


def setup_inputs(seed: int = 0) -> dict:
    key = jax.random.key(seed)
    ks = jax.random.split(key, 24)
    f32 = jnp.float32
    L = DEPTH

    def nrm(k, shape, scale):
        return jax.random.normal(k, shape, f32) * scale

    def gain(k, n):
        return 1.0 + 0.02 * jax.random.normal(k, (L, n), f32)

    return {
        "x": jax.random.normal(ks[0], (BATCH, SEQ, D_MODEL), f32),
        "mem": jax.random.normal(ks[1], (BATCH, N_MEM, D_MODEL), f32),
        "attn_norm": gain(ks[2], D_MODEL),
        "w_in": nrm(ks[3], (L, D_MODEL, IN_WIDTH), D_MODEL ** -0.5),
        "q_norm": gain(ks[4], HEAD_DIM),
        "k_norm": gain(ks[5], HEAD_DIM),
        "pool_proj": nrm(ks[6], (L, len(POOL_WINDOWS), POOL_GROUP, POOL_GROUP), POOL_GROUP ** -0.5),
        "pool_scale": gain(ks[7], POOL_WIDTH),
        "mem_norm": gain(ks[8], D_MODEL),
        "w_mem_kv": nrm(ks[9], (L, D_MODEL, 2 * MEM_WIDTH), D_MODEL ** -0.5),
        "mq_norm": gain(ks[10], MEM_HEAD_DIM),
        "mk_norm": gain(ks[11], MEM_HEAD_DIM),
        "w_out": nrm(ks[12], (L, MIX_WIDTH, D_MODEL), MIX_WIDTH ** -0.5),
        "ffn_norm": gain(ks[13], D_MODEL),
        "w_group": nrm(ks[14], (L, D_MODEL, N_GROUPS), D_MODEL ** -0.5),
        "b_group": nrm(ks[15], (L, N_GROUPS), 0.01),
        "w_router": nrm(ks[16], (L, N_GROUPS, D_MODEL, EXPERTS_PER_GROUP), D_MODEL ** -0.5),
        "b_router": nrm(ks[17], (L, N_GROUPS, EXPERTS_PER_GROUP), 0.01),
        "w1": nrm(ks[18], (L, N_EXPERTS, D_MODEL, EXPERT_HIDDEN), D_MODEL ** -0.5),
        "w3": nrm(ks[19], (L, N_EXPERTS, D_MODEL, EXPERT_HIDDEN), D_MODEL ** -0.5),
        "w2": nrm(ks[20], (L, N_EXPERTS, EXPERT_HIDDEN, D_MODEL), EXPERT_HIDDEN ** -0.5),
    }


def reference(x, mem, attn_norm, w_in, q_norm, k_norm, pool_proj, pool_scale, mem_norm, w_mem_kv,
              mq_norm, mk_norm, w_out, ffn_norm, w_group, b_group, w_router, b_router, w1, w3, w2):
    for l in range(DEPTH):
        x = _layer(x, mem, attn_norm[l], w_in[l], q_norm[l], k_norm[l], pool_proj[l], pool_scale[l],
                   mem_norm[l], w_mem_kv[l], mq_norm[l], mk_norm[l], w_out[l], ffn_norm[l],
                   w_group[l], b_group[l], w_router[l], b_router[l], w1[l], w3[l], w2[l])
    return x
```

```cpp
#include <hip/hip_runtime.h>
#include <cstdio>
#include <cstdint>

#define LAS __attribute__((address_space(3)))
#define GAS __attribute__((address_space(1)))
typedef unsigned short bf16;
typedef short bf16x8 __attribute__((ext_vector_type(8)));
typedef short s16x4 __attribute__((ext_vector_type(4)));
typedef float f32x4 __attribute__((ext_vector_type(4)));
typedef float f32x16 __attribute__((ext_vector_type(16)));
typedef float f32x2 __attribute__((ext_vector_type(2)));
typedef __bf16 bf16x2_t __attribute__((ext_vector_type(2)));
typedef unsigned u32x4 __attribute__((ext_vector_type(4)));
typedef unsigned u32x2 __attribute__((ext_vector_type(2)));
typedef GAS unsigned gu32;
typedef int v4i __attribute__((ext_vector_type(4)));
typedef int v8i __attribute__((ext_vector_type(8)));

constexpr int BATCH = 4, SEQ = 4096, DM = 1024, T = BATCH * SEQ;
constexpr int INW = 2048, NMEM = 256;
constexpr int NEXP = 64, EH = 512, CAP = 32768;
constexpr float EPS = 1e-6f;
constexpr float W13_SCALE = 64.f, W2_SCALE = 32.f, H_SCALE = 4.f, F8MAX = 448.f;
constexpr float C2 = 0.125f * 1.4426950408889634f;
constexpr int ZQ = 0, ZK = 512, ZV = 1024, ZU = 1536, ZQM = 1792;

constexpr size_t MiB = 1u << 20;
constexpr size_t WS_CTL = 0, CTL_ZERO_BYTES = 1 * MiB;
constexpr size_t WS_RS = 1 * MiB;
constexpr size_t WS_RSTD = 1 * MiB + 128 * 1024;
constexpr size_t WS_SSQ = 2 * MiB;
constexpr size_t WS_WIN = 4 * MiB;
constexpr size_t WS_WOUT = 8 * MiB;
constexpr size_t WS_RT = 10 * MiB;
constexpr size_t WS_KVM = 11 * MiB;
constexpr size_t WS_TOKPOS = 12 * MiB;
constexpr size_t WS_ROWTOK = 13 * MiB;
constexpr size_t WS_ROWGATE = 21 * MiB;
constexpr size_t WS_LP = 29 * MiB;
constexpr size_t WS_ROWRSTD = 50 * MiB;
constexpr size_t WS_XB = 480 * MiB;
constexpr size_t WS_XG = 480 * MiB;
constexpr size_t WS_Z = 416 * MiB;
constexpr size_t WS_W13 = 416 * MiB;
constexpr size_t WS_YB = 416 * MiB;
constexpr size_t WS_MIX = 384 * MiB;
constexpr size_t WS_W2 = 384 * MiB;
constexpr size_t WS_PO = 336 * MiB;
constexpr size_t WS_X1Q = 336 * MiB;
constexpr size_t WS_HMID = 356 * MiB;
constexpr size_t WS_END = 512 * MiB;
constexpr int CW_CNT = 16384, CNT_STRIDE = 64;
constexpr int CW_BAR = 4096;

constexpr int RING_BYTES = 131072;
constexpr int WSCR_OFF = RING_BYTES;
constexpr int TAB_OFF = WSCR_OFF + 2048;
constexpr int LDSCTL_OFF = TAB_OFF + 2048, MISC_OFF = LDSCTL_OFF;
constexpr int RSC_OFF = LDSCTL_OFF + 1024;
constexpr int LDS_BYTES = 147456;
constexpr int RTK_OFF = RSC_OFF + 3072;
constexpr int GZ_OFF = RTK_OFF + 2048;
static_assert(GZ_OFF + 768 <= LDS_BYTES, "LDS map");

#define RLX_AGENT __ATOMIC_RELAXED, __HIP_MEMORY_SCOPE_AGENT
#define LDS_WAIT() asm volatile("s_waitcnt lgkmcnt(0)" ::: "memory")
#define VM_WAIT() asm volatile("s_waitcnt vmcnt(0)" ::: "memory")
__device__ __forceinline__ unsigned f2bf(float f) { unsigned u = __builtin_bit_cast(unsigned, f); return (u + 0x7fffu + ((u >> 16) & 1u)) >> 16; }
__device__ __forceinline__ unsigned pk2(float lo, float hi) { f32x2 v = {lo, hi}; bf16x2_t b = __builtin_convertvector(v, bf16x2_t); return __builtin_bit_cast(unsigned, b); }
__device__ __forceinline__ unsigned pk4f8(float a, float b, float c, float d) {
    a = __builtin_amdgcn_fmed3f(a, -F8MAX, F8MAX); b = __builtin_amdgcn_fmed3f(b, -F8MAX, F8MAX); c = __builtin_amdgcn_fmed3f(c, -F8MAX, F8MAX); d = __builtin_amdgcn_fmed3f(d, -F8MAX, F8MAX);
    int w = 0; w = __builtin_amdgcn_cvt_pk_fp8_f32(a, b, w, false); w = __builtin_amdgcn_cvt_pk_fp8_f32(c, d, w, true); return (unsigned)w; }
__device__ __forceinline__ v8i cat8(bf16x8 a, bf16x8 b) { const v4i x = __builtin_bit_cast(v4i, a), y = __builtin_bit_cast(v4i, b); return __builtin_shufflevector(x, y, 0, 1, 2, 3, 4, 5, 6, 7); }
__device__ __forceinline__ float bf2f(unsigned short h) { return __builtin_bit_cast(float, (unsigned)h << 16); }
__device__ __forceinline__ float bflo(unsigned w) { return __builtin_bit_cast(float, w << 16); }
__device__ __forceinline__ float bfhi(unsigned w) { return __builtin_bit_cast(float, w & 0xffff0000u); }
__device__ __forceinline__ float wave_sum(float v) {
#pragma unroll
    for (int o = 1; o < 64; o <<= 1) v += __shfl_xor(v, o);
    return v;
}
__device__ __forceinline__ int crow(int r, int hi) { return (r & 3) + 8 * (r >> 2) + 4 * hi; }

namespace pg8 {
constexpr int BM = 256, BK = 64, HALF = 128, HTB = HALF * BK * 2, NXCD = 8, WGM = 8;
__host__ __device__ __forceinline__ int lds_byte(int r, int c) { const int st = (r >> 4) * 2 + (c >> 5), rr = r & 15, cc = c & 31, ob = rr * 64 + cc * 2; return st * 1024 + (ob ^ (((ob >> 9) & 1) << 5)); }
__host__ __device__ __forceinline__ void stage_rc(int b, int& R, int& C) { const int st = b / 1024, sb = b % 1024, swz = sb ^ (((sb >> 9) & 1) << 5); R = (st >> 1) * 16 + swz / 64; C = (st & 1) * 32 + (swz % 64) / 2; }
__host__ __device__ __forceinline__ int perm32(int rho) { const int n = rho >> 4, i = rho & 15; return 8 * (i >> 2) + 4 * n + (i & 3); }

struct Unit { int pm, pn, e, mt, cnt, light; };
struct Gemm { const bf16* A; const bf16* Bt; int K; };

struct StaticOrder {
    int nM, nN, nwg, G, c;
    __device__ void init(int M, int N, int G_, int c_) { nM = M / BM; nN = N / BM; nwg = nM * nN; G = G_; c = c_; }
    __device__ bool next(int i, Unit& u) const {
        const long L = (long)i * G + c; if (L >= nwg) return false;
        int wgid = (int)L; { const int q = nwg / NXCD, r = nwg % NXCD, xcd = wgid % NXCD, off = wgid / NXCD; wgid = (xcd < r ? xcd * (q + 1) : r * (q + 1) + (xcd - r) * q) + off; }
        const int nig = WGM * nN, gid = wgid / nig, fm = gid * WGM, gsz = (nM - fm) < WGM ? (nM - fm) : WGM;
        u.pm = fm + ((wgid % nig) % gsz); u.pn = (wgid % nig) / gsz; u.e = 0; u.mt = 0; u.cnt = 0; u.light = 0; return true;
    }
    __device__ __forceinline__ int row(const Unit&, int) const { return 0; }
    __device__ __forceinline__ int row_lds(const Unit&, int, const LAS unsigned*) const { return 0; }
    __device__ __forceinline__ const unsigned* rtk_src(const Unit&) const { return nullptr; }
};
struct GroupOrder {
    const LAS int* tab;
    const unsigned* rowtok;
    int G, c;
    __device__ bool next(int i, Unit& u) const {
        const int NUH = tab[129 + 64] * 4, NUL = tab[194 + 64] * 4; long L = (long)i * G + c; if (L >= NUH + NUL) return false;
        const int lt = L >= NUH; const int NU = lt ? NUL : NUH; int wgid = (int)(lt ? L - NUH : L);
        { const int q = NU / NXCD, r = NU % NXCD, xcd = wgid % NXCD, off = wgid / NXCD; wgid = (xcd < r ? xcd * (q + 1) : r * (q + 1) + (xcd - r) * q) + off; }
        const int xt = wgid >> 2, pnl = wgid & 3, base = lt ? 194 : 129; int lo = 0;
#pragma unroll
        for (int st = 32; st >= 1; st >>= 1) { if (tab[base + lo + st] <= xt) lo += st; }
        const int ts = tab[64 + lo], ntl = tab[64 + lo + 1] - ts, mt = lt ? ntl - 1 : xt - tab[129 + lo];
        u.pm = ts + mt; u.pn = lo * 4 + pnl; u.e = lo; u.mt = mt; u.cnt = tab[lo]; u.light = lt; return true;
    }
    __device__ __forceinline__ int row(const Unit& u, int rl) const { const int idx = u.mt * 256 + rl; return idx < u.cnt ? (int)rowtok[(size_t)u.e * CAP + idx] : T; }
    __device__ __forceinline__ int row_lds(const Unit& u, int rl, const LAS unsigned* rt) const { const int idx = u.mt * 256 + rl; const int v = (int)rt[rl]; return idx < u.cnt ? v : T; }
    __device__ __forceinline__ const unsigned* rtk_src(const Unit& u) const { return rowtok + (size_t)u.e * CAP + u.mt * 256; }
};

template <class Epi, class Sched, bool GATHER, bool F8>
__device__ __forceinline__ void gemm_phase(LAS unsigned char* lds, const Gemm g, const Sched& S, const Epi& E) {
    int tid = threadIdx.x; asm volatile("" : "+v"(tid));
    const int wid = __builtin_amdgcn_readfirstlane(tid >> 6), lane = tid & 63, wr = wid >> 2, wc = wid & 3, fr = lane & 15, fq = lane >> 4;
    const int K = g.K, nt = K / BK;
    unsigned voffA[2], voffB[2]; int RA[2], CA[2];
#pragma unroll
    for (int i = 0; i < 2; ++i) { int R, C; stage_rc(tid * 16 + i * 8192, R, C); const int Rb = Epi::PERM ? ((R & ~31) + perm32(R & 31)) : R;
        voffA[i] = (unsigned)(R * K + C) * 2u; voffB[i] = (unsigned)(Rb * K + C) * 2u; RA[i] = R; CA[i] = C; }
    const size_t kstep = (size_t)(BK * 2);
    const size_t hstep = (size_t)HALF * K * 2;
    const size_t tstep = 2 * hstep;
    const unsigned ldsw = (unsigned)wid * 1024u;
    const int aoff = lds_byte(wr * 64 + fr, fq * 8), boff = lds_byte(wc * 32 + fr, fq * 8);
    const char* gAb = (const char*)g.A;
    unsigned goff[2][2];
#define PG8_SA(b, h) (((b) * 2 + (h)) * HTB)
#define PG8_SB(b, h) ((4 + (b) * 2 + (h)) * HTB)
#define PG8_STAGE(bufoff, gbase, voff) do { _Pragma("unroll") for (int _i = 0; _i < 2; ++_i) \
        __builtin_amdgcn_global_load_lds((const unsigned*)((const char*)(gbase) + (voff)[_i]), (LAS unsigned*)(lds + (bufoff) + ldsw + _i * 8192), 16, 0, 0); } while (0)
#define PG8_STAGE_A(bufoff, h, base, kb) do { if constexpr (GATHER) { PG8_STAGE(bufoff, gAb + (kb), goff[h]); } else { PG8_STAGE(bufoff, (base) + (size_t)(h) * hstep + (kb), voffA); } } while (0)
#define PG8_SETG(u) do { if constexpr (GATHER) { _Pragma("unroll") for (int _h = 0; _h < 2; ++_h) _Pragma("unroll") for (int _i = 0; _i < 2; ++_i) \
        goff[_h][_i] = ((unsigned)S.row(u, _h * HALF + RA[_i]) * (unsigned)K + (unsigned)CA[_i]) * 2u; } } while (0)
#define PG8_SETG_LDS(u, slot) do { if constexpr (GATHER) { const LAS unsigned* rt_ = (const LAS unsigned*)(lds + RTK_OFF + (slot) * 1024); _Pragma("unroll") for (int _h = 0; _h < 2; ++_h) _Pragma("unroll") for (int _i = 0; _i < 2; ++_i) \
        goff[_h][_i] = ((unsigned)S.row_lds(u, _h * HALF + RA[_i], rt_) * (unsigned)K + (unsigned)CA[_i]) * 2u; } } while (0)
#define PG8_RTK(u, slot) do { if constexpr (GATHER) { if (wid == 1) { const unsigned* rp_ = S.rtk_src(u); unsigned keep_; const unsigned dst_ = (unsigned)(uintptr_t)(lds + RTK_OFF + (slot) * 1024); \
        asm volatile("s_mov_b32 %0, m0\n\ts_mov_b32 m0, %2\n\ts_nop 0\n\tglobal_load_lds_dwordx4 %1, off\n\ts_mov_b32 m0, %0" : "=&s"(keep_) : "v"(rp_ + lane * 4), "s"(dst_) : "memory"); } } } while (0)
#define PG8_LDA(dst, b, h) do { _Pragma("unroll") for (int m = 0; m < 4; ++m) dst[m] = cat8(*(const LAS bf16x8*)(lds + PG8_SA(b, h) + aoff + m * 2048), *(const LAS bf16x8*)(lds + PG8_SA(b, h) + aoff + m * 2048 + 1024)); } while (0)
#define PG8_LDB(dst, b, h) do { _Pragma("unroll") for (int n = 0; n < 2; ++n) dst[n] = cat8(*(const LAS bf16x8*)(lds + PG8_SB(b, h) + boff + n * 2048), *(const LAS bf16x8*)(lds + PG8_SB(b, h) + boff + n * 2048 + 1024)); } while (0)
#define PG8_LO(x) __builtin_bit_cast(bf16x8, __builtin_shufflevector(x, x, 0, 1, 2, 3))
#define PG8_HI(x) __builtin_bit_cast(bf16x8, __builtin_shufflevector(x, x, 4, 5, 6, 7))
#define PG8_MMA(ai, bj, At, Bt) do { __builtin_amdgcn_s_setprio(1); _Pragma("unroll") for (int m = 0; m < 4; ++m) _Pragma("unroll") for (int n = 0; n < 2; ++n) { \
        if constexpr (F8) asm volatile("v_mfma_f32_16x16x128_f8f6f4 %0, %1, %2, %0" : "+v"(acc[ai][bj][m][n]) : "v"(Bt[n]), "v"(At[m])); \
        else { acc[ai][bj][m][n] = __builtin_amdgcn_mfma_f32_16x16x32_bf16(PG8_LO(Bt[n]), PG8_LO(At[m]), acc[ai][bj][m][n], 0, 0, 0); \
               acc[ai][bj][m][n] = __builtin_amdgcn_mfma_f32_16x16x32_bf16(PG8_HI(Bt[n]), PG8_HI(At[m]), acc[ai][bj][m][n], 0, 0, 0); } } __builtin_amdgcn_s_setprio(0); } while (0)
#define PG8_WAIT_V(n) asm volatile("s_waitcnt vmcnt(" #n ")" ::: "memory")
#define PG8_WAIT_L(n) asm volatile("s_waitcnt lgkmcnt(" #n ")" ::: "memory")
#define PG8_BAR __builtin_amdgcn_s_barrier()
#define PG8_SCHED __builtin_amdgcn_sched_barrier(0)
    Unit cur, nxt; int ui = 0;
    if (!S.next(0, cur)) return;
#define PG8_RSC(u, slot) do { if (wid == 0) { const float* rp_ = E.rsc_src(u); if (rp_) { unsigned keep_; const unsigned dst_ = (unsigned)(uintptr_t)(lds + RSC_OFF + (slot) * 1024); \
        asm volatile("s_mov_b32 %0, m0\n\ts_mov_b32 m0, %2\n\ts_nop 0\n\tglobal_load_lds_dwordx4 %1, off\n\ts_mov_b32 m0, %0" : "=&s"(keep_) : "v"(rp_ + lane * 4), "s"(dst_) : "memory"); } } } while (0)
    PG8_RSC(cur, 0);
    f32x4 acc[2][2][4][2];
#pragma unroll
    for (int a = 0; a < 2; ++a)
#pragma unroll
        for (int b = 0; b < 2; ++b)
#pragma unroll
            for (int m = 0; m < 4; ++m)
#pragma unroll
                for (int n = 0; n < 2; ++n) acc[a][b][m][n] = (f32x4){0.f, 0.f, 0.f, 0.f};
    v8i At[4], B0[2], B1[2];
    const char* cA = (const char*)g.A + (size_t)cur.pm * tstep; const char* cB = (const char*)g.Bt + (size_t)cur.pn * tstep;
    PG8_SETG(cur);
    PG8_STAGE(PG8_SB(0, 0), cB, voffB); PG8_STAGE(PG8_SB(0, 1), cB + hstep, voffB); PG8_STAGE_A(PG8_SA(0, 0), 0, cA, 0); PG8_STAGE_A(PG8_SA(0, 1), 1, cA, 0);
    if (wr == 1) PG8_BAR;
    PG8_WAIT_V(2); PG8_BAR;
    PG8_STAGE(PG8_SB(1, 0), cB + kstep, voffB); PG8_STAGE_A(PG8_SA(1, 0), 0, cA, kstep); PG8_STAGE(PG8_SB(1, 1), cB + hstep + kstep, voffB);
    PG8_WAIT_V(6); PG8_BAR;
    for (;;) {
        const bool has_next = S.next(ui + 1, nxt);
        if (has_next) { PG8_RSC(nxt, (ui + 1) % 3); PG8_RTK(nxt, (ui + 1) & 1); }
        const char* nA = has_next ? (const char*)g.A + (size_t)nxt.pm * tstep : cA; const char* nB = has_next ? (const char*)g.Bt + (size_t)nxt.pn * tstep : cB;
#pragma unroll 1
        for (int t = 0; t < nt; t += 2) {
            const bool last = (t == nt - 2);
            const size_t k1 = (size_t)(t + 1) * kstep, k2 = last ? 0 : (size_t)(t + 2) * kstep, k3 = k2 + kstep;
            const char* pa2 = last ? nA : cA; const char* pb2 = last ? nB : cB;
            PG8_LDB(B0, 0, 0); PG8_LDB(B1, 0, 1); PG8_SCHED; PG8_LDA(At, 0, 0); PG8_STAGE_A(PG8_SA(1, 1), 1, cA, k1);
            if constexpr (GATHER) { if (last && has_next) PG8_SETG_LDS(nxt, (ui + 1) & 1); }
            PG8_WAIT_V(8); PG8_WAIT_L(0); PG8_BAR; PG8_MMA(0, 0, At, B0); PG8_MMA(0, 1, At, B1); PG8_BAR; PG8_SCHED;
            if (!cur.light) PG8_LDA(At, 0, 1); PG8_STAGE(PG8_SB(0, 0), pb2 + k2, voffB); PG8_STAGE(PG8_SB(0, 1), pb2 + hstep + k2, voffB); PG8_STAGE_A(PG8_SA(0, 0), 0, pa2, k2);
            PG8_WAIT_V(8); PG8_WAIT_L(0); PG8_BAR; if (!cur.light) { PG8_MMA(1, 0, At, B0); PG8_MMA(1, 1, At, B1); } PG8_BAR; PG8_SCHED;
            PG8_LDB(B0, 1, 0); PG8_LDB(B1, 1, 1); PG8_SCHED; PG8_LDA(At, 1, 0); PG8_STAGE_A(PG8_SA(0, 1), 1, pa2, k2);
            PG8_WAIT_V(8); PG8_WAIT_L(0); PG8_BAR; PG8_MMA(0, 0, At, B0); PG8_MMA(0, 1, At, B1); PG8_BAR; PG8_SCHED;
            if (!cur.light) PG8_LDA(At, 1, 1); PG8_STAGE(PG8_SB(1, 0), pb2 + k3, voffB); PG8_STAGE(PG8_SB(1, 1), pb2 + hstep + k3, voffB); PG8_STAGE_A(PG8_SA(1, 0), 0, pa2, k3);
            PG8_WAIT_V(8); PG8_WAIT_L(0); PG8_BAR; if (!cur.light) { PG8_MMA(1, 0, At, B0); PG8_MMA(1, 1, At, B1); } PG8_BAR; PG8_SCHED;
        }
        if constexpr (F8) { asm volatile("s_nop 15\n\ts_nop 15" ::: "memory"); PG8_SCHED; }
        if (wr == 0) PG8_BAR;
        E(acc, cur, wr, wc, fr, fq, (const LAS float*)(lds + RSC_OFF + (ui % 3) * 1024));
        if (!has_next) break;
#pragma unroll
        for (int a = 0; a < 2; ++a)
#pragma unroll
            for (int b = 0; b < 2; ++b)
#pragma unroll
                for (int m = 0; m < 4; ++m)
#pragma unroll
                    for (int n = 0; n < 2; ++n) acc[a][b][m][n] = (f32x4){0.f, 0.f, 0.f, 0.f};
        cur = nxt; cA = nA; cB = nB; ++ui;
        if (wr == 1) PG8_BAR;
    }
    PG8_WAIT_V(0);
    PG8_BAR;
#undef PG8_SA
#undef PG8_SB
#undef PG8_STAGE
#undef PG8_STAGE_A
#undef PG8_SETG
#undef PG8_SETG_LDS
#undef PG8_RTK
#undef PG8_LDA
#undef PG8_LDB
#undef PG8_RSC
#undef PG8_LO
#undef PG8_HI
#undef PG8_MMA
#undef PG8_WAIT_V
#undef PG8_WAIT_L
#undef PG8_BAR
#undef PG8_SCHED
}

struct EpiZ {
    static constexpr bool PERM = true;
    bf16* Z; const float* rs; const LAS float* gz;
    __device__ __forceinline__ const float* rsc_src(const Unit& u) const { return rs + (size_t)u.pm * BM; }
    __device__ __forceinline__ void operator()(const f32x4 (&acc)[2][2][4][2], const Unit& u, int wr, int wc, int fr, int fq, const LAS float* rsc) const {
        const int pn = u.pn;
        const LAS float* gp = pn < 2 ? gz : (pn < 4 ? gz + 64 : (pn == 7 ? gz + 128 : nullptr));
        f32x4 gv[2][2];
#pragma unroll
        for (int bj = 0; bj < 2; ++bj)
#pragma unroll
            for (int n = 0; n < 2; ++n) gv[bj][n] = gp ? *(const LAS f32x4*)(gp + 32 * bj + 8 * fq + 4 * n) : (f32x4){1.f, 1.f, 1.f, 1.f};
        const int col0 = 256 * pn + 64 * wc + 8 * fq;
#pragma unroll
        for (int ai = 0; ai < 2; ++ai)
#pragma unroll
            for (int m = 0; m < 4; ++m) {
                const int rl = ai * HALF + wr * 64 + m * 16 + fr, row = u.pm * BM + rl; const float r = rsc[rl];
                f32x4 v[2][2]; float ss = 0.f;
#pragma unroll
                for (int bj = 0; bj < 2; ++bj)
#pragma unroll
                    for (int n = 0; n < 2; ++n) { v[bj][n] = acc[ai][bj][m][n] * r; const f32x4 q = v[bj][n] * v[bj][n]; ss += (q[0] + q[1]) + (q[2] + q[3]); }
                if (gp) { ss += __shfl_xor(ss, 16); ss += __shfl_xor(ss, 32); const float rn = 1.0f / sqrtf(ss * (1.f / 64.f) + EPS);
#pragma unroll
                    for (int bj = 0; bj < 2; ++bj)
#pragma unroll
                        for (int n = 0; n < 2; ++n) v[bj][n] = v[bj][n] * rn * gv[bj][n]; }
                bf16* rowp = Z + ((size_t)(4 * pn + wc) * T + row) * 64 + 8 * fq;
#pragma unroll
                for (int bj = 0; bj < 2; ++bj) { u32x4 w; w.x = pk2(v[bj][0][0], v[bj][0][1]); w.y = pk2(v[bj][0][2], v[bj][0][3]); w.z = pk2(v[bj][1][0], v[bj][1][1]); w.w = pk2(v[bj][1][2], v[bj][1][3]);
                    *(u32x4*)(rowp + 32 * bj) = w; }
            }
    }
};
struct EpiX1 {
    static constexpr bool PERM = true;
    const bf16* xb; bf16* x1b; float* ssq;
    __device__ __forceinline__ const float* rsc_src(const Unit&) const { return nullptr; }
    __device__ __forceinline__ void operator()(const f32x4 (&acc)[2][2][4][2], const Unit& u, int wr, int wc, int fr, int fq, const LAS float*) const {
        const int col0 = u.pn * BM + wc * 32 + 8 * fq;
#pragma unroll
        for (int ai = 0; ai < 2; ++ai)
#pragma unroll
            for (int m = 0; m < 4; ++m) {
                const int row = u.pm * BM + ai * HALF + wr * 64 + m * 16 + fr; const size_t off = (size_t)row * DM + col0; float ss = 0.f;
#pragma unroll
                for (int bj = 0; bj < 2; ++bj) { f32x4 x1[2]; const u32x4 xw = *(const u32x4*)(xb + off + bj * HALF);
                    x1[0] = (f32x4){bflo(xw.x), bfhi(xw.x), bflo(xw.y), bfhi(xw.y)} + acc[ai][bj][m][0]; x1[1] = (f32x4){bflo(xw.z), bfhi(xw.z), bflo(xw.w), bfhi(xw.w)} + acc[ai][bj][m][1];
#pragma unroll
                    for (int n = 0; n < 2; ++n) { const f32x4 q = x1[n] * x1[n]; ss += (q[0] + q[1]) + (q[2] + q[3]); }
                    u32x4 w; w.x = pk2(x1[0][0], x1[0][1]); w.y = pk2(x1[0][2], x1[0][3]); w.z = pk2(x1[1][0], x1[1][1]); w.w = pk2(x1[1][2], x1[1][3]);
                    *(u32x4*)(x1b + off + bj * HALF) = w; }
                ss += __shfl_xor(ss, 16); ss += __shfl_xor(ss, 32);
                if (fq == 0) ssq[(size_t)row * 16 + u.pn * 4 + wc] = ss;
            }
    }
};
struct EpiH {
    static constexpr bool PERM = true;
    unsigned char* H; const float* rowrstd;
    __device__ __forceinline__ const float* rsc_src(const Unit& u) const { return rowrstd + (size_t)u.e * CAP + u.mt * 256; }
    __device__ __forceinline__ void operator()(const f32x4 (&acc)[2][2][4][2], const Unit& u, int wr, int wc, int fr, int fq, const LAS float* rsc) const {
        const int pnl = u.pn & 3, col0 = 128 * pnl + 32 * wc + 8 * fq;
#pragma unroll
        for (int ai = 0; ai < 2; ++ai) { if (ai == 1 && u.light) break;
#pragma unroll
            for (int m = 0; m < 4; ++m) {
                const int rl = ai * HALF + wr * 64 + m * 16 + fr, idx = u.mt * 256 + rl; const bool valid = idx < u.cnt;
                const float rs = valid ? rsc[rl] * (1.0f / W13_SCALE) : 0.f;
                float h[8];
#pragma unroll
                for (int n = 0; n < 2; ++n)
#pragma unroll
                    for (int e = 0; e < 4; ++e) { const float a = acc[ai][0][m][n][e] * rs, b = acc[ai][1][m][n][e] * rs;
                        const float sg = __builtin_amdgcn_rcpf(1.0f + __builtin_amdgcn_exp2f(-1.4426950408889634f * a)); h[4 * n + e] = a * sg * b * H_SCALE; }
                u32x2 w; w.x = pk4f8(h[0], h[1], h[2], h[3]); w.y = pk4f8(h[4], h[5], h[6], h[7]);
                *(u32x2*)(H + (size_t)(u.pm * BM + rl) * EH + col0) = w;
            } }
    }
};
struct EpiY {
    static constexpr bool PERM = true;
    bf16* Y; const float* rowgate; const LAS int* tab;
    __device__ __forceinline__ const float* rsc_src(const Unit& u) const { return rowgate + (size_t)u.e * CAP + u.mt * 256; }
    __device__ __forceinline__ void operator()(const f32x4 (&acc)[2][2][4][2], const Unit& u, int wr, int wc, int fr, int fq, const LAS float* rsc) const {
        const int pnl = u.pn & 3, col0 = 256 * pnl + 32 * wc + 8 * fq;
#pragma unroll
        for (int ai = 0; ai < 2; ++ai) { if (ai == 1 && u.light) break;
#pragma unroll
            for (int m = 0; m < 4; ++m) {
                const int rl = ai * HALF + wr * 64 + m * 16 + fr, idx = u.mt * 256 + rl; const bool valid = idx < u.cnt;
                const float gt = valid ? rsc[rl] * (1.0f / (W2_SCALE * H_SCALE)) : 0.f;
                if (!valid) continue;
                bf16* rowp = Y + (size_t)(tab[259 + u.e] + idx) * DM + col0;
#pragma unroll
                for (int bj = 0; bj < 2; ++bj) { const f32x4 v0 = acc[ai][bj][m][0] * gt, v1 = acc[ai][bj][m][1] * gt;
                    u32x4 w; w.x = pk2(v0[0], v0[1]); w.y = pk2(v0[2], v0[3]); w.z = pk2(v1[0], v1[1]); w.w = pk2(v1[2], v1[3]); *(u32x4*)(rowp + bj * HALF) = w; }
            } }
    }
};
}

#define XB_TMO      128
#define XB_XCNT(j)  (256  + 64 * (j))
#define XB_XSUB(j)  (1280 + 64 * (j))
#define XB_XGEN(j)  (2304 + 64 * (j))
#define XB_TOP      3328
#define XB_TOPGEN   3392
#define XCD_BAR_WORDS 3456
#define XB_SPIN_CAP (1u << 18)
__device__ __forceinline__ unsigned xb_ld(unsigned* p)              { return __hip_atomic_load(p, __ATOMIC_RELAXED, __HIP_MEMORY_SCOPE_AGENT); }
__device__ __forceinline__ unsigned xb_add(unsigned* p, unsigned v) { return __hip_atomic_fetch_add(p, v, __ATOMIC_RELAXED, __HIP_MEMORY_SCOPE_AGENT); }
__device__ __forceinline__ unsigned xb_xcc_id() { return (unsigned)__builtin_amdgcn_s_getreg((3 << 11) | 20) & 0xFu; }
#define XB_SPIN(cond, bar) do { unsigned _sp = 0; while (cond) { __builtin_amdgcn_s_sleep(1); \
    if ((++_sp & 255u) == 0u) { if (xb_ld(&(bar)[XB_TMO])) break; if (_sp > XB_SPIN_CAP) { atomicAdd(&(bar)[XB_TMO], 1u); break; } } } } while (0)
struct XcdBarrier { unsigned* bar; unsigned x; volatile LAS unsigned* st; };
__device__ __forceinline__ XcdBarrier xcd_barrier_post(unsigned* bar, volatile LAS unsigned* st) {
    XcdBarrier b; b.bar = bar; b.x = xb_xcc_id(); b.st = st;
    if (threadIdx.x == 0) (void)xb_add(&bar[XB_XCNT(b.x)], 1u);
    return b;
}
__device__ __forceinline__ void xcd_barrier_complete(unsigned* bar, unsigned x, unsigned& nloc, unsigned& nx) {
    const unsigned G = gridDim.x * gridDim.y * gridDim.z;
    unsigned sum, cnt, mine, sp = 0u;
    for (;;) {
        sum = 0u; cnt = 0u; mine = 0u;
#pragma unroll
        for (unsigned j = 0; j < 16; ++j) { const unsigned c = xb_ld(&bar[XB_XCNT(j)]); sum += c; cnt += (c > 0u) ? 1u : 0u; mine = (j == x) ? c : mine; }
        if (sum == G) break;
        __builtin_amdgcn_s_sleep(1);
        if ((++sp & 255u) == 0u) { if (xb_ld(&bar[XB_TMO])) break; if (sp > XB_SPIN_CAP) { atomicAdd(&bar[XB_TMO], 1u); break; } }
    }
    nloc = mine > 0u ? mine : 1u; nx = cnt > 0u ? cnt : 1u;
}
__device__ __forceinline__ void xcd_barrier(const XcdBarrier& b) {
    asm volatile("s_waitcnt vmcnt(0)" ::: "memory");
    __syncthreads();
    if (threadIdx.x == 0) {
        unsigned* bar = b.bar;
        __builtin_amdgcn_s_waitcnt(0);
        unsigned nloc = b.st[0], nx = b.st[1];
        if (nloc == 0u) { xcd_barrier_complete(bar, b.x, nloc, nx); b.st[0] = nloc; b.st[1] = nx; }
        const unsigned old = xb_add(&bar[XB_XSUB(b.x)], 1u);
        const unsigned gen = old / nloc;
        if (old + 1u == (gen + 1u) * nloc) {
            __builtin_amdgcn_fence(__ATOMIC_RELEASE, "agent");
            asm volatile("s_waitcnt vmcnt(0)" ::: "memory");
            const unsigned og = xb_add(&bar[XB_TOP], 1u);
            const unsigned tg = og / nx;
            if (og + 1u == (tg + 1u) * nx) xb_add(&bar[XB_TOPGEN], 1u);
            else XB_SPIN(xb_ld(&bar[XB_TOPGEN]) == tg, bar);
            __builtin_amdgcn_fence(__ATOMIC_ACQUIRE, "agent");
            xb_add(&bar[XB_XGEN(b.x)], 1u);
            asm volatile("s_waitcnt vmcnt(0)" ::: "memory");
        } else {
            XB_SPIN(xb_ld(&bar[XB_XGEN(b.x)]) == gen, bar);
            __builtin_amdgcn_fence(__ATOMIC_ACQUIRE, "agent");
            asm volatile("s_waitcnt vmcnt(0)" ::: "memory");
        }
    }
    __syncthreads();
}

struct XbTicket { unsigned last, gen, tg; };
__device__ __forceinline__ XbTicket xcd_barrier_arrive(const XcdBarrier& b) {
    asm volatile("s_waitcnt vmcnt(0)" ::: "memory");
    __syncthreads();
    XbTicket t; t.last = 0u; t.gen = 0u; t.tg = 0u;
    if (threadIdx.x == 0) {
        unsigned* bar = b.bar;
        __builtin_amdgcn_s_waitcnt(0);
        unsigned nloc = b.st[0], nx = b.st[1];
        if (nloc == 0u) { xcd_barrier_complete(bar, b.x, nloc, nx); b.st[0] = nloc; b.st[1] = nx; }
        const unsigned old = xb_add(&bar[XB_XSUB(b.x)], 1u);
        t.gen = old / nloc;
        if (old + 1u == (t.gen + 1u) * nloc) {
            t.last = 1u;
            __builtin_amdgcn_fence(__ATOMIC_RELEASE, "agent");
            asm volatile("s_waitcnt vmcnt(0)" ::: "memory");
            const unsigned og = xb_add(&bar[XB_TOP], 1u);
            t.tg = og / nx;
            if (og + 1u == (t.tg + 1u) * nx) { xb_add(&bar[XB_TOPGEN], 1u); t.last = 2u; }
        }
    }
    return t;
}
__device__ __forceinline__ void xcd_barrier_wait(const XcdBarrier& b, const XbTicket& t) {
    asm volatile("s_waitcnt vmcnt(0)" ::: "memory");
    if (threadIdx.x == 0) {
        unsigned* bar = b.bar;
        if (t.last != 0u) {
            if (t.last == 1u) XB_SPIN(xb_ld(&bar[XB_TOPGEN]) == t.tg, bar);
            __builtin_amdgcn_fence(__ATOMIC_ACQUIRE, "agent");
            xb_add(&bar[XB_XGEN(b.x)], 1u);
            asm volatile("s_waitcnt vmcnt(0)" ::: "memory");
        } else {
            XB_SPIN(xb_ld(&bar[XB_XGEN(b.x)]) == t.gen, bar);
            __builtin_amdgcn_fence(__ATOMIC_ACQUIRE, "agent");
            asm volatile("s_waitcnt vmcnt(0)" ::: "memory");
        }
    }
    __syncthreads();
}

struct Args { const float* in[21]; float* out; unsigned char* ws; unsigned char* wsh; int ph_lo, ph_hi; };
struct Frame {
    LAS unsigned char* lds; int tid, lane, wave, vcu, G;
    const float* in[21]; float* out; unsigned char* ws; unsigned char* wsh;
};

__device__ __forceinline__ void p0_item(const float* W, int N, const float* gain, int k0, int n0, bf16* WT, int Kd, size_t drow0, LAS float* scr, int lane) {
#pragma unroll 8
    for (int i = 0; i < 32; ++i) { const int kk = 2 * i + (lane >> 5); float v = __builtin_nontemporal_load(W + (size_t)(k0 + kk) * N + n0 + (lane & 31)); if (gain) v *= gain[k0 + kk]; scr[kk * 33 + (lane & 31)] = v; }
    LDS_WAIT(); asm volatile("" ::: "memory");
    const int c = lane & 7;
#pragma unroll
    for (int j = 0; j < 4; ++j) { const int n = (lane >> 3) + 8 * j; const LAS float* s = scr + (8 * c) * 33 + n;
        u32x4 o; o.x = pk2(s[0 * 33], s[1 * 33]); o.y = pk2(s[2 * 33], s[3 * 33]); o.z = pk2(s[4 * 33], s[5 * 33]); o.w = pk2(s[6 * 33], s[7 * 33]);
        *(GAS u32x4*)(WT + (drow0 + n) * (size_t)Kd + k0 + 8 * c) = o; }
    LDS_WAIT(); asm volatile("" ::: "memory");
}
__device__ __forceinline__ void p0_poolfold_item(const float* Wout, const float* proj, const float* scale, int item, bf16* WT, int lane) {
    const int g = item >> 7, cb = (item >> 4) & 7, nb = item & 15, n = nb * 64 + lane, c0 = cb * 8;
    float acc[8];
#pragma unroll
    for (int j = 0; j < 8; ++j) acc[j] = 0.f;
    const float* pr = proj + (size_t)(g * 64 + c0) * 64;
#pragma unroll 8
    for (int e = 0; e < 64; ++e) { const float wo = Wout[(size_t)(512 + 64 * g + e) * DM + n] * scale[64 * g + e];
#pragma unroll
        for (int j = 0; j < 8; ++j) acc[j] += pr[j * 64 + e] * wo; }
    u32x4 o; o.x = pk2(acc[0], acc[1]); o.y = pk2(acc[2], acc[3]); o.z = pk2(acc[4], acc[5]); o.w = pk2(acc[6], acc[7]);
    *(GAS u32x4*)(WT + (size_t)n * DM + 512 + 64 * g + c0) = o;
}
__device__ __forceinline__ void p0_xrow(const float* xrow, bf16* orow, float* rs, int lane) {
    const GAS f32x4* xr = (const GAS f32x4*)xrow + lane;
    f32x4 v[4]; float s = 0.f;
#pragma unroll
    for (int j = 0; j < 4; ++j) { v[j] = xr[64 * j]; s += (v[j].x * v[j].x + v[j].y * v[j].y) + (v[j].z * v[j].z + v[j].w * v[j].w); }
    s = wave_sum(s);
    if (lane == 0) *rs = 1.0f / sqrtf(s * (1.f / DM) + EPS);
    GAS unsigned long long* o8 = (GAS unsigned long long*)orow + lane;
#pragma unroll
    for (int j = 0; j < 4; ++j) o8[64 * j] = (unsigned long long)pk2(v[j].x, v[j].y) | ((unsigned long long)pk2(v[j].z, v[j].w) << 32);
}
__device__ __forceinline__ void p0_memkv(Frame& F, int task, LAS float* myscr, LAS float* grpscr  ) {
    const float* mem = F.in[1]; const float* mnorm = F.in[8]; const float* wkv = F.in[9]; const float* mkn = F.in[11];
    bf16* kvm = (bf16*)(F.ws + WS_KVM);
    const int lane = F.lane, i = lane & 15, kk = lane >> 4, kq = F.wave & 3;
    const int rb = task >> 3, cb = task & 7, row = rb * 16 + i;
    f32x4 acc[4];
#pragma unroll
    for (int nb = 0; nb < 4; ++nb) acc[nb] = (f32x4){0.f, 0.f, 0.f, 0.f};
    float ss = 0.f;
    const float* arow = mem + (size_t)row * DM;
    const float* wb = wkv + cb * 64 + i;
#pragma unroll 2
    for (int st = 0; st < 8; ++st) {
        const int k0 = 256 * kq + 32 * st + 8 * kk;
        const f32x4 a0 = *(const f32x4*)(arow + k0), a1 = *(const f32x4*)(arow + k0 + 4), g0 = *(const f32x4*)(mnorm + k0), g1 = *(const f32x4*)(mnorm + k0 + 4);
        float bv[4][8];
#pragma unroll
        for (int nb = 0; nb < 4; ++nb)
#pragma unroll
            for (int j = 0; j < 8; ++j) bv[nb][j] = wb[(size_t)(k0 + j) * 512 + nb * 16];
        ss += ((a0[0] * a0[0] + a0[1] * a0[1]) + (a0[2] * a0[2] + a0[3] * a0[3])) + ((a1[0] * a1[0] + a1[1] * a1[1]) + (a1[2] * a1[2] + a1[3] * a1[3]));
        const f32x4 p0 = a0 * g0, p1 = a1 * g1;
        u32x4 aw; aw.x = pk2(p0[0], p0[1]); aw.y = pk2(p0[2], p0[3]); aw.z = pk2(p1[0], p1[1]); aw.w = pk2(p1[2], p1[3]);
        const bf16x8 a8 = __builtin_bit_cast(bf16x8, aw);
#pragma unroll
        for (int nb = 0; nb < 4; ++nb) { u32x4 bw; bw.x = pk2(bv[nb][0], bv[nb][1]); bw.y = pk2(bv[nb][2], bv[nb][3]); bw.z = pk2(bv[nb][4], bv[nb][5]); bw.w = pk2(bv[nb][6], bv[nb][7]);
            acc[nb] = __builtin_amdgcn_mfma_f32_16x16x32_bf16(a8, __builtin_bit_cast(bf16x8, bw), acc[nb], 0, 0, 0); }
    }
#pragma unroll
    for (int nb = 0; nb < 4; ++nb)
#pragma unroll
        for (int r = 0; r < 4; ++r) myscr[(nb * 4 + r) * 64 + lane] = acc[nb][r];
    myscr[1024 + lane] = ss;
    LDS_WAIT(); __syncthreads();
    if (kq == 0) {
        float ssum = 0.f;
#pragma unroll
        for (int w = 0; w < 4; ++w) ssum += grpscr[w * 4096 + 1024 + lane];
        ssum += __shfl_xor(ssum, 16); ssum += __shfl_xor(ssum, 32);
        const float rsm = 1.0f / sqrtf(ssum * (1.f / DM) + EPS);
        float v[4][4];
#pragma unroll
        for (int nb = 0; nb < 4; ++nb)
#pragma unroll
            for (int r = 0; r < 4; ++r) { float s = 0.f;
#pragma unroll
                for (int w = 0; w < 4; ++w) s += grpscr[w * 4096 + (nb * 4 + r) * 64 + lane];
                v[nb][r] = s; }
#pragma unroll
        for (int r = 0; r < 4; ++r) { const int rowD = 4 * kk + r; const float rr = __shfl(rsm, rowD);
#pragma unroll
            for (int nb = 0; nb < 4; ++nb) v[nb][r] *= rr; }
        if (cb < 4) {
#pragma unroll
            for (int r = 0; r < 4; ++r) { float s2 = 0.f;
#pragma unroll
                for (int nb = 0; nb < 4; ++nb) s2 += v[nb][r] * v[nb][r];
                s2 += __shfl_xor(s2, 1); s2 += __shfl_xor(s2, 2); s2 += __shfl_xor(s2, 4); s2 += __shfl_xor(s2, 8);
                const float rn = 1.0f / sqrtf(s2 * (1.f / 64.f) + EPS);
#pragma unroll
                for (int nb = 0; nb < 4; ++nb) v[nb][r] *= rn * mkn[nb * 16 + i]; }
        }
#pragma unroll
        for (int r = 0; r < 4; ++r)
#pragma unroll
            for (int nb = 0; nb < 4; ++nb) kvm[(size_t)(rb * 16 + 4 * kk + r) * 512 + cb * 64 + nb * 16 + i] = (bf16)f2bf(v[nb][r]);
    }
    __syncthreads();
}

template <int PART>
__device__ __forceinline__ void p0_prologue(Frame& F) {
    LAS float* scr = (LAS float*)(F.lds + F.wave * 16384);
    const int gw = F.vcu * 8 + F.wave, NGW = F.G * 8;
    if constexpr (PART == 1) for (int t2 = F.vcu; t2 < 256; t2 += F.G) p0_memkv(F, t2 * 2 + (F.wave >> 2), scr, (LAS float*)(F.lds + (F.wave & 4) * 16384));
    const float* attn_norm = F.in[2]; const float* w_in = F.in[3]; const float* w_out = F.in[12];
    bf16* WinT = (bf16*)(F.ws + WS_WIN); bf16* WoutT = (bf16*)(F.ws + WS_WOUT);
    constexpr int I_IN = 16 * 64, I_OUT = 12 * 32, I_FOLD = 512;
    constexpr int NITEMS = PART == 0 ? I_IN : I_OUT + I_FOLD;
    if constexpr (PART == 0 || PART == 2) for (int it = gw; it < NITEMS; it += NGW) {
        int r = it + (PART == 2 ? I_IN : 0);
        if (r < I_IN) { const int kb = r >> 6, nb = r & 63, n0 = nb * 32;
            const int pn = n0 >> 8, wc = (n0 >> 6) & 3, bj = (n0 >> 5) & 1; const size_t drow = (size_t)(256 * pn + 128 * bj + 32 * wc);
            p0_item(w_in, INW, attn_norm, kb * 64, n0, WinT, DM, drow, scr, F.lane); continue; }
        r -= I_IN;
        if (r < I_OUT) { int kb = r >> 5; const int nb = r & 31; if (kb >= 8) kb += 4;
            p0_item(w_out, DM, nullptr, kb * 64, nb * 32, WoutT, DM, (size_t)nb * 32, scr, F.lane); continue; }
        r -= I_OUT;
        p0_poolfold_item(w_out, F.in[6], F.in[7], r, WoutT, F.lane);
    }
    if constexpr (PART == 0) { const float* x = F.in[0]; bf16* XB = (bf16*)(F.wsh + WS_XB); float* RS = (float*)(F.ws + WS_RS);
      for (int m = gw; m < T; m += 2 * NGW) {
          const int m2 = m + NGW; const bool has2 = m2 < T;
          const GAS f32x4* xa = (const GAS f32x4*)(x + (size_t)m * DM) + F.lane; const GAS f32x4* xb2 = (const GAS f32x4*)(x + (size_t)(has2 ? m2 : m) * DM) + F.lane;
          f32x4 va[4], vb[4]; float sa = 0.f, sb = 0.f;
#pragma unroll
          for (int j = 0; j < 4; ++j) { va[j] = __builtin_nontemporal_load(&xa[64 * j]); vb[j] = __builtin_nontemporal_load(&xb2[64 * j]); }
#pragma unroll
          for (int j = 0; j < 4; ++j) { sa += (va[j].x * va[j].x + va[j].y * va[j].y) + (va[j].z * va[j].z + va[j].w * va[j].w); sb += (vb[j].x * vb[j].x + vb[j].y * vb[j].y) + (vb[j].z * vb[j].z + vb[j].w * vb[j].w); }
          sa = wave_sum(sa); sb = wave_sum(sb);
          if (F.lane == 0) { RS[m] = 1.0f / sqrtf(sa * (1.f / DM) + EPS); if (has2) RS[m2] = 1.0f / sqrtf(sb * (1.f / DM) + EPS); }
          GAS unsigned long long* oa = (GAS unsigned long long*)(XB + (size_t)m * DM) + F.lane;
#pragma unroll
          for (int j = 0; j < 4; ++j) oa[64 * j] = (unsigned long long)pk2(va[j].x, va[j].y) | ((unsigned long long)pk2(va[j].z, va[j].w) << 32);
          if (has2) { GAS unsigned long long* ob = (GAS unsigned long long*)(XB + (size_t)m2 * DM) + F.lane;
#pragma unroll
              for (int j = 0; j < 4; ++j) ob[64 * j] = (unsigned long long)pk2(vb[j].x, vb[j].y) | ((unsigned long long)pk2(vb[j].z, vb[j].w) << 32); } } }
    if constexpr (PART == 3) { bf16* RT = (bf16*)(F.ws + WS_RT); const float* wg = F.in[14]; const float* wr = F.in[16];
      const int gt = F.vcu * 512 + F.tid, NGT = F.G * 512;
      for (int idx = gt; idx < 96 * 1024; idx += NGT) { const int j = idx >> 10, k = idx & 1023; float v = 0.f;
          if (j < 8) v = wg[k * 8 + j]; else if (j < 72) v = wr[(size_t)((j - 8) >> 3) * 8192 + k * 8 + ((j - 8) & 7)];
          RT[idx] = (bf16)f2bf(v * F.in[13][k]); }
    }
}

__device__ __forceinline__ void cv_item_f8(const float* W, int N, const float* gain, float scale, int k0, int n0, unsigned char* WT, int Kd, size_t drow0, LAS unsigned* scr, int lane) {
#pragma unroll 1
    for (int qt = 0; qt < 4; ++qt) {
        const int kh = k0 + 64 * qt;
        const float* wp = W + (size_t)kh * N + n0 + lane;
        float v[64];
#pragma unroll
        for (int i = 0; i < 64; ++i) v[i] = __builtin_nontemporal_load(wp + (size_t)i * N);
        if (gain) {
#pragma unroll
            for (int i = 0; i < 64; ++i) v[i] *= gain[kh + i]; }
#pragma unroll
        for (int q = 0; q < 16; ++q) { const int kq = 16 * qt + q; scr[kq * 64 + (lane ^ (2 * (kq >> 2)))] = pk4f8(v[4 * q] * scale, v[4 * q + 1] * scale, v[4 * q + 2] * scale, v[4 * q + 3] * scale); }
    }
    LDS_WAIT(); asm volatile("" ::: "memory");
    const int c = lane & 15;
#pragma unroll
    for (int j = 0; j < 16; ++j) { const int n = (lane >> 4) + 4 * j; const LAS unsigned* sp = scr + (4 * c) * 64 + (n ^ (2 * c));
        u32x4 o; o.x = sp[0]; o.y = sp[64]; o.z = sp[128]; o.w = sp[192];
        *(GAS u32x4*)(WT + (drow0 + n) * (size_t)Kd + k0 + 16 * c) = o; }
    LDS_WAIT(); asm volatile("" ::: "memory");
}
template <int PART>
__device__ __forceinline__ void expert_convert(Frame& F) {
    LAS unsigned* scr = (LAS unsigned*)(F.lds + F.wave * 16384);
    const int gw = F.vcu * 8 + F.wave, NGW = F.G * 8;
    unsigned char* W13Q = F.wsh + WS_W13; unsigned char* W2Q = F.wsh + WS_W2;
    constexpr int I_E1 = 4 * 8, I_E2 = 2 * 16, PER = PART == 0 ? 2 * I_E1 : I_E2;
    for (int r = gw; r < NEXP * PER; r += NGW) {
        const int e = r / PER; int q = r % PER; if (PART == 1) q += 2 * I_E1;
        if (q < 2 * I_E1) { const int s = q >= I_E1; q -= s * I_E1; const int kb = q >> 3, nb = q & 7, f0 = nb * 64;
            const float* W = (s ? F.in[19] : F.in[18]) + (size_t)e * DM * EH;
            const size_t drow = (size_t)e * 1024 + 256 * (f0 >> 7) + 128 * s + (f0 & 127);
            cv_item_f8(W, EH, F.in[13], W13_SCALE, kb * 256, f0, W13Q, DM, drow, scr, F.lane); }
        else { q -= 2 * I_E1; const int kb = q >> 4, nb = q & 15;
            const float* W = F.in[20] + (size_t)e * EH * DM;
            cv_item_f8(W, DM, nullptr, W2_SCALE, kb * 256, nb * 64, W2Q, EH, (size_t)e * 1024 + nb * 64, scr, F.lane); }
    }
}

struct ATask { const bf16* qp; const bf16* kp; const bf16* vp; bf16* op; float* lp; long qstride, kvstride, ostride; int kfirst, jmin, jmax, lstride; };
__device__ __forceinline__ ATask p2_make_task(const Frame& F, int t, int b, int ci, int h) {
    const bf16* Z = (const bf16*)(F.wsh + WS_Z); const bf16* KVM = (const bf16*)(F.ws + WS_KVM); bf16* MIX = (bf16*)(F.wsh + WS_MIX);
    bf16* PO = (bf16*)(F.wsh + WS_PO); float* LP = (float*)(F.ws + WS_LP);
    ATask a; const long rowbase = (long)b * SEQ; const int s0 = ci * 512;
    if (t == 0) { const int mh = h & 3, sb = 8 * (h >> 2) + F.wave; const long tok0 = rowbase + s0 + 32 * sb;
        a.qp = Z + ((size_t)(28 + mh) * T + tok0) * 64; a.qstride = 64; a.kp = KVM + (size_t)b * NMEM * 512 + 64 * mh; a.vp = a.kp + 256; a.kvstride = 512; a.kfirst = 0; a.jmin = 0; a.jmax = 7;
        a.op = MIX + tok0 * DM + 768 + 64 * mh; a.ostride = DM; a.lp = nullptr; a.lstride = 0; }
    else { const int pat = (t - 1) >> 1, half = (t - 1) & 1, dil = pat == 0 ? 1 : (pat == 1 ? 4 : 16), tk = F.wave + 8 * half;
        int res, q0sub;
        if (pat == 0) { res = 0; q0sub = s0 + 32 * tk; } else if (pat == 1) { res = tk >> 2; q0sub = s0 / 4 + 32 * (tk & 3); } else { res = tk; q0sub = s0 / 16; }
        const long qtok = rowbase + (long)dil * q0sub + res;
        a.qp = Z + ((size_t)h * T + qtok) * 64; a.qstride = (long)dil * 64; a.kp = Z + ((size_t)(8 + h) * T + rowbase + res) * 64; a.vp = a.kp + (size_t)8 * T * 64; a.kvstride = (long)dil * 64;
        a.kfirst = q0sub - 128; a.jmin = q0sub >= 128 ? 0 : (128 - q0sub) / 32; a.jmax = 4;
        a.op = PO + ((size_t)pat * T + qtok) * 512 + 64 * h; a.ostride = (long)dil * 512; a.lp = LP + ((size_t)pat * T + qtok) * 8 + h; a.lstride = dil * 8; }
    return a;
}
__device__ __forceinline__ void kload4(bf16x8 (&k)[4], const bf16* p) {
    asm volatile("global_load_dwordx4 %0, %4, off\n\tglobal_load_dwordx4 %1, %4, off offset:32\n\tglobal_load_dwordx4 %2, %4, off offset:64\n\tglobal_load_dwordx4 %3, %4, off offset:96"
                 : "=&v"(k[0]), "=&v"(k[1]), "=&v"(k[2]), "=&v"(k[3]) : "v"(p) : "memory");
}
__device__ __forceinline__ void glds16(const void* gsrc, unsigned lds_dst) { unsigned keep;
    asm volatile("s_mov_b32 %0, m0\n\ts_mov_b32 m0, %2\n\ts_nop 0\n\tglobal_load_lds_dwordx4 %1, off\n\ts_mov_b32 m0, %0" : "=&s"(keep) : "v"(gsrc), "s"(lds_dst) : "memory"); }
__device__ __forceinline__ void p2_attention(Frame& F) {
    const bf16* Z = (const bf16*)(F.wsh + WS_Z); bf16* MIX = (bf16*)(F.wsh + WS_MIX);
    const bf16* PO = (const bf16*)(F.wsh + WS_PO); const float* LP = (const float*)(F.ws + WS_LP);
    LAS unsigned char* wl = F.lds + F.wave * 16384; LAS float* wsf = (LAS float*)(F.lds + WSCR_OFF + F.wave * 256);
    const unsigned wl0 = (unsigned)(uintptr_t)wl;
    const int lane = F.lane, r32 = lane & 31, hi = lane >> 5;
    const int vlane = ((lane >> 4) & 1) * 32 + (lane & 3) * 8 + (4 * hi + ((lane & 15) >> 2)) * 64;
    for (int cid = F.vcu; cid < 256; cid += F.G) {
        const int b = cid >> 6, h = 4 * ((cid >> 5) & 1) + (cid & 3), ci = (cid >> 2) & 7;
        const int s0 = ci * 512; const long rowbase = (long)b * SEQ;
        { LAS unsigned char* pl = F.lds; const int g = h >> 1;
          { const bf16* up = Z + ((size_t)(24 + (h >> 1)) * T + rowbase + s0 + F.tid) * 64 + 32 * (h & 1); u32x4 v[4];
#pragma unroll
            for (int q = 0; q < 4; ++q) v[q] = *(const u32x4*)(up + 8 * q);
            u32x4 hv[4];
            if (F.tid < 15) {
#pragma unroll
                for (int q = 0; q < 4; ++q) hv[q] = (s0 > 0) ? *(const u32x4*)(up - 15L * 64 + 8 * q) : (u32x4){0u, 0u, 0u, 0u}; }
#pragma unroll
            for (int q = 0; q < 4; ++q) *(LAS u32x4*)(pl + (F.tid + 15) * 80 + 16 * q) = v[q];
            if (F.tid < 15) {
#pragma unroll
                for (int q = 0; q < 4; ++q) *(LAS u32x4*)(pl + F.tid * 80 + 16 * q) = hv[q]; } }
          LDS_WAIT(); __syncthreads();
          const int s = s0 + F.tid, w = 2 << g, cnt = (s + 1 < w) ? s + 1 : w;
          float a[32];
#pragma unroll
          for (int c = 0; c < 32; ++c) a[c] = 0.f;
          u32x4 us[4];
          const LAS unsigned char* pr = pl + (F.tid + 15) * 80;
#pragma unroll
          for (int q = 0; q < 4; ++q) us[q] = *(const LAS u32x4*)(pr + 16 * q);
#pragma unroll 2
          for (int r = 0; r < w; ++r) {
#pragma unroll
              for (int q = 0; q < 4; ++q) { const u32x4 v = *(const LAS u32x4*)(pr - r * 80 + 16 * q);
                  a[8 * q + 0] += bflo(v.x); a[8 * q + 1] += bfhi(v.x); a[8 * q + 2] += bflo(v.y); a[8 * q + 3] += bfhi(v.y);
                  a[8 * q + 4] += bflo(v.z); a[8 * q + 5] += bfhi(v.z); a[8 * q + 6] += bflo(v.w); a[8 * q + 7] += bfhi(v.w); } }
          const float inv = 1.0f / (float)cnt;
          bf16* op = MIX + (rowbase + s) * DM + 512 + 32 * h;
#pragma unroll
          for (int q = 0; q < 4; ++q) { u32x4 w4;
              w4.x = pk2(a[8 * q + 0] * inv - bflo(us[q].x), a[8 * q + 1] * inv - bfhi(us[q].x)); w4.y = pk2(a[8 * q + 2] * inv - bflo(us[q].y), a[8 * q + 3] * inv - bfhi(us[q].y));
              w4.z = pk2(a[8 * q + 4] * inv - bflo(us[q].z), a[8 * q + 5] * inv - bfhi(us[q].z)); w4.w = pk2(a[8 * q + 6] * inv - bflo(us[q].w), a[8 * q + 7] * inv - bfhi(us[q].w));
              *(u32x4*)(op + 8 * q) = w4; }
          LDS_WAIT(); __syncthreads(); }
        VM_WAIT();
        ATask ia = p2_make_task(F, 0, b, ci, h), ca = ia; int it = 0, ij = ia.jmin, ct = 0, cj = ia.jmin;
        bf16x8 kA[4], kB[4], kC[4], qr[4];
        const LAS unsigned char* qb = wl + 12288;
#define P2_QDMA(A) do { const bf16* qs_ = (A).qp + (long)(lane >> 3) * (A).qstride + (lane & 7) * 8; \
            _Pragma("unroll") for (int i_ = 0; i_ < 4; ++i_) glds16(qs_ + (long)(8 * i_) * (A).qstride, (unsigned)__builtin_amdgcn_readfirstlane(wl0 + 12288 + i_ * 1024)); } while (0)
#define P2_QREAD() do { _Pragma("unroll") for (int d0 = 0; d0 < 4; ++d0) qr[d0] = *(const LAS bf16x8*)(qb + r32 * 128 + d0 * 32 + hi * 16); LDS_WAIT(); asm volatile("" ::: "memory"); } while (0)
        P2_QDMA(ca);
        asm volatile("s_waitcnt vmcnt(0)" ::: "memory");
        P2_QREAD();
        { const ATask na = p2_make_task(F, 1, b, ci, h); P2_QDMA(na); }
#define P2_ISSUE(KS, slot) do { const long tb_ = (long)(ia.kfirst + 32 * ij) * ia.kvstride; \
            kload4(KS, ia.kp + tb_ + (long)r32 * ia.kvstride + 8 * hi); \
            const bf16* vt_ = ia.vp + tb_ + (long)(lane >> 2) * ia.kvstride + (lane & 3) * 8; \
            _Pragma("unroll") for (int i_ = 0; i_ < 4; ++i_) glds16(vt_ + (long)(i_ & 1) * 16 * ia.kvstride + (i_ >> 1) * 32, (unsigned)__builtin_amdgcn_readfirstlane(wl0 + (slot) * 4096 + i_ * 1024)); \
            if (ij < ia.jmax) ++ij; else if (it < 6) { ++it; ia = p2_make_task(F, it, b, ci, h); ij = ia.jmin; } } while (0)
        P2_ISSUE(kA, 0); P2_ISSUE(kB, 1);
        f32x16 o[2]; float lacc = 0.f;
#pragma unroll
        for (int r = 0; r < 16; ++r) { o[0][r] = 0.f; o[1][r] = 0.f; }
        bool done = false;
#define P2_STEP(KC, KI, slotc, sloti) do { \
            P2_ISSUE(KI, sloti); \
            asm volatile("s_waitcnt vmcnt(16) ; KSET %0 %1 %2 %3" : "+v"(KC[0]), "+v"(KC[1]), "+v"(KC[2]), "+v"(KC[3]) :: "memory"); \
            __builtin_amdgcn_sched_barrier(0); \
              \
            const LAS unsigned char* vb = wl + (slotc) * 4096; \
            bf16x8 vf[2][2]; \
            _Pragma("unroll") for (int d0 = 0; d0 < 2; ++d0) { \
                _Pragma("unroll") for (int ks = 0; ks < 2; ++ks) { \
                    const LAS unsigned char* vp_ = vb + (d0 * 2 + ks) * 1024 + vlane; \
                    const s16x4 lo = __builtin_bit_cast(s16x4, __builtin_amdgcn_ds_read_tr16_b64_v4i16((LAS s16x4*)vp_)); \
                    const s16x4 hh = __builtin_bit_cast(s16x4, __builtin_amdgcn_ds_read_tr16_b64_v4i16((LAS s16x4*)(vp_ + 512))); \
                    vf[d0][ks] = (bf16x8){lo[0], lo[1], lo[2], lo[3], hh[0], hh[1], hh[2], hh[3]}; } } \
            __builtin_amdgcn_sched_barrier(0); \
            f32x16 p; \
            _Pragma("unroll") for (int r = 0; r < 16; ++r) p[r] = 0.f; \
            _Pragma("unroll") for (int d0 = 0; d0 < 4; ++d0) p = __builtin_amdgcn_mfma_f32_32x32x16_bf16(KC[d0], qr[d0], p, 0, 0, 0); \
            const int mm = (ct > 0) ? (cj == 0 ? 1 : (cj == 4 ? 2 : 0)) : 0; \
            _Pragma("unroll") for (int r = 0; r < 16; ++r) p[r] = __builtin_amdgcn_exp2f(p[r]); \
            if (mm != 0) { const int klo = (mm == 1) ? r32 : -1, khi = (mm == 2) ? r32 : 64; \
                _Pragma("unroll") for (int r = 0; r < 16; ++r) { const int kj = crow(r, hi); p[r] = (kj >= klo && kj <= khi) ? p[r] : 0.f; } } \
            lacc += (((p[0] + p[1]) + (p[2] + p[3])) + ((p[4] + p[5]) + (p[6] + p[7]))) + (((p[8] + p[9]) + (p[10] + p[11])) + ((p[12] + p[13]) + (p[14] + p[15]))); \
            u32x4 pw0, pw1; \
            pw0.x = pk2(p[0], p[1]); pw0.y = pk2(p[2], p[3]); pw0.z = pk2(p[4], p[5]); pw0.w = pk2(p[6], p[7]); \
            pw1.x = pk2(p[8], p[9]); pw1.y = pk2(p[10], p[11]); pw1.z = pk2(p[12], p[13]); pw1.w = pk2(p[14], p[15]); \
            const bf16x8 pa0 = __builtin_bit_cast(bf16x8, pw0), pa1 = __builtin_bit_cast(bf16x8, pw1); \
            _Pragma("unroll") for (int d0 = 0; d0 < 2; ++d0) { \
                _Pragma("unroll") for (int ks = 0; ks < 2; ++ks) o[d0] = __builtin_amdgcn_mfma_f32_32x32x16_bf16(ks ? pa1 : pa0, vf[d0][ks], o[d0], 0, 0, 0); } \
            asm volatile("" ::: "memory"); \
            if (cj == ca.jmax) { \
                LAS bf16* stg = (LAS bf16*)(wl + (slotc) * 4096);            \
                const float l = lacc + __shfl_xor(lacc, 32); \
                if (hi == 0) wsf[r32] = 1.0f / l; \
                LDS_WAIT(); asm volatile("" ::: "memory"); \
                _Pragma("unroll") for (int r = 0; r < 16; ++r) { const int qq = crow(r, hi); const float iv = wsf[qq]; \
                    _Pragma("unroll") for (int d0 = 0; d0 < 2; ++d0) stg[qq * 64 + 32 * d0 + r32] = (bf16)f2bf(o[d0][r] * iv); } \
                LDS_WAIT(); asm volatile("" ::: "memory"); \
                u32x4 ov[4]; \
                _Pragma("unroll") for (int i_ = 0; i_ < 4; ++i_) ov[i_] = *(const LAS u32x4*)(stg + (i_ * 8 + (lane >> 3)) * 64 + (lane & 7) * 8); \
                LDS_WAIT(); asm volatile("" ::: "memory"); \
                if (ct < 6) { asm volatile("s_waitcnt vmcnt(8)" ::: "memory");     \
                    P2_QREAD(); \
                    if (ct < 5) { const ATask na = p2_make_task(F, ct + 2, b, ci, h); P2_QDMA(na); } } \
                if (hi == 0 && ca.lp) ca.lp[(long)r32 * ca.lstride] = l; \
                _Pragma("unroll") for (int i_ = 0; i_ < 4; ++i_) *(u32x4*)(ca.op + (long)(i_ * 8 + (lane >> 3)) * ca.ostride + (lane & 7) * 8) = ov[i_]; \
                if (ct == 6) done = true; \
                else { ++ct; ca = p2_make_task(F, ct, b, ci, h); cj = ca.jmin; \
                    _Pragma("unroll") for (int r = 0; r < 16; ++r) { o[0][r] = 0.f; o[1][r] = 0.f; } lacc = 0.f; } \
            } else ++cj; } while (0)
        for (;;) {
            P2_STEP(kA, kC, 0, 2); if (done) break;
            P2_STEP(kB, kA, 1, 0); if (done) break;
            P2_STEP(kC, kB, 2, 1); if (done) break;
        }
#undef P2_STEP
#undef P2_ISSUE
#undef P2_QDMA
#undef P2_QREAD
        asm volatile("s_waitcnt vmcnt(0) ; KSETS %0 %1 %2" : "+v"(kA[0]), "+v"(kB[0]), "+v"(kC[0]) :: "memory");
        asm volatile("" : "+v"(kA[1]), "+v"(kA[2]), "+v"(kA[3]), "+v"(kB[1]), "+v"(kB[2]), "+v"(kB[3]), "+v"(kC[1]), "+v"(kC[2]), "+v"(kC[3]));
        __syncthreads();
        { const long row = rowbase + s0 + F.tid;
          const float l0 = LP[((size_t)0 * T + row) * 8 + h], l1 = LP[((size_t)1 * T + row) * 8 + h], l2 = LP[((size_t)2 * T + row) * 8 + h];
          const float il = 1.0f / (l0 + l1 + l2), w0 = l0 * il, w1 = l1 * il, w2 = l2 * il;
          const bf16* p0 = PO + ((size_t)0 * T + row) * 512 + 64 * h; const bf16* p1 = PO + ((size_t)1 * T + row) * 512 + 64 * h; const bf16* p2 = PO + ((size_t)2 * T + row) * 512 + 64 * h;
          bf16* op = MIX + row * DM + 64 * h;
#pragma unroll
          for (int c = 0; c < 8; ++c) { const u32x4 a = *(const u32x4*)(p0 + 8 * c), bb = *(const u32x4*)(p1 + 8 * c), cc = *(const u32x4*)(p2 + 8 * c); u32x4 w;
              w.x = pk2(w0 * bflo(a.x) + w1 * bflo(bb.x) + w2 * bflo(cc.x), w0 * bfhi(a.x) + w1 * bfhi(bb.x) + w2 * bfhi(cc.x));
              w.y = pk2(w0 * bflo(a.y) + w1 * bflo(bb.y) + w2 * bflo(cc.y), w0 * bfhi(a.y) + w1 * bfhi(bb.y) + w2 * bfhi(cc.y));
              w.z = pk2(w0 * bflo(a.z) + w1 * bflo(bb.z) + w2 * bflo(cc.z), w0 * bfhi(a.z) + w1 * bfhi(bb.z) + w2 * bfhi(cc.z));
              w.w = pk2(w0 * bflo(a.w) + w1 * bflo(bb.w) + w2 * bflo(cc.w), w0 * bfhi(a.w) + w1 * bfhi(bb.w) + w2 * bfhi(cc.w));
              *(u32x4*)(op + 8 * c) = w; } }
        VM_WAIT(); __syncthreads();
    }
}

__device__ __forceinline__ void p4_router(Frame& F) {
    const bf16* XG = (const bf16*)(F.wsh + WS_XG); const bf16* RT = (const bf16*)(F.ws + WS_RT); const float* SSQ = (const float*)(F.ws + WS_SSQ);
    unsigned* TOKPOS = (unsigned*)(F.ws + WS_TOKPOS); unsigned* ROWTOK = (unsigned*)(F.ws + WS_ROWTOK); float* ROWGATE = (float*)(F.ws + WS_ROWGATE);
    unsigned* CNT = (unsigned*)(F.ws + WS_CTL) + CW_CNT; float* ROWRSTD = (float*)(F.ws + WS_ROWRSTD);
    const float* bg = F.in[15]; const float* br = F.in[17]; unsigned char* X1Q = F.wsh + WS_X1Q;
    LAS float* PL = (LAS float*)F.lds;
    LAS unsigned* hist = (LAS unsigned*)(F.lds + 100352); LAS unsigned* hbase = hist + 64;
    const int lane = F.lane, r32 = lane & 31, hi = lane >> 5, tb = F.wave >> 2, kq = F.wave & 3;
    if (F.vcu == 0 && F.tid < 256) ((unsigned*)(X1Q + (size_t)T * DM))[F.tid] = 0u;
    for (int tg = F.vcu; tg < T / 64; tg += F.G) {
        const int tok = tg * 64 + tb * 32 + r32;
        f32x16 acc[3];
#pragma unroll
        for (int nb = 0; nb < 3; ++nb)
#pragma unroll
            for (int r = 0; r < 16; ++r) acc[nb][r] = 0.f;
        const bf16* ap = XG + (size_t)tok * DM + 256 * kq + 8 * hi; const bf16* bp = RT + (size_t)r32 * DM + 256 * kq + 8 * hi;
#pragma unroll 4
        for (int s = 0; s < 16; ++s) { const bf16x8 a = *(const bf16x8*)(ap + 16 * s);
            { const u32x4 aw = __builtin_bit_cast(u32x4, a); u32x2 q8; q8.x = pk4f8(bflo(aw.x), bfhi(aw.x), bflo(aw.y), bfhi(aw.y)); q8.y = pk4f8(bflo(aw.z), bfhi(aw.z), bflo(aw.w), bfhi(aw.w));
              *(u32x2*)(X1Q + (size_t)tok * DM + 256 * kq + 16 * s + 8 * hi) = q8; }
#pragma unroll
            for (int nb = 0; nb < 3; ++nb) { const bf16x8 bb = *(const bf16x8*)(bp + (size_t)nb * 32 * DM + 16 * s); acc[nb] = __builtin_amdgcn_mfma_f32_32x32x16_bf16(bb, a, acc[nb], 0, 0, 0); } }
        LAS float* pw = PL + (size_t)(F.wave * 32 + r32) * 97;
#pragma unroll
        for (int nb = 0; nb < 3; ++nb)
#pragma unroll
            for (int r = 0; r < 16; ++r) pw[32 * nb + crow(r, hi)] = acc[nb][r];
        if (F.tid < 64) hist[F.tid] = 0u;
        LDS_WAIT(); __syncthreads();
        int e1 = 0, e2 = 0; unsigned k1 = 0, k2 = 0; float g1 = 0.f, g2 = 0.f, rstdv = 0.f;
        if (F.tid < 64) {
            const int t2 = F.tid >> 5, rr = F.tid & 31, tk = tg * 64 + F.tid;
            const LAS float* p0 = PL + (size_t)((t2 * 4) * 32 + rr) * 97;
#define LOGIT(n) (p0[(n)] + p0[32 * 97 + (n)] + p0[64 * 97 + (n)] + p0[96 * 97 + (n)])
            float ss = 0.f;
#pragma unroll
            for (int i = 0; i < 4; ++i) { const f32x4 v = *(const f32x4*)(SSQ + (size_t)tk * 16 + 4 * i); ss += (v[0] + v[1]) + (v[2] + v[3]); }
            const float rstd = 1.0f / sqrtf(ss * (1.f / DM) + EPS);
            float lg[8]; int g = 0; float gm = -3.0e38f;
#pragma unroll
            for (int j = 0; j < 8; ++j) { lg[j] = rstd * LOGIT(j) + bg[j]; if (lg[j] > gm) { gm = lg[j]; g = j; } }
            float den = 0.f;
#pragma unroll
            for (int j = 0; j < 8; ++j) den += __expf(lg[j] - gm);
            const float pg = 1.0f / den;
            float le[8]; int i1 = 0; float v1 = -3.0e38f;
#pragma unroll
            for (int j = 0; j < 8; ++j) { le[j] = rstd * LOGIT(8 + 8 * g + j) + br[8 * g + j]; if (le[j] > v1) { v1 = le[j]; i1 = j; } }
            int i2 = 0; float v2 = -3.0e38f;
#pragma unroll
            for (int j = 0; j < 8; ++j) { if (j != i1 && le[j] > v2) { v2 = le[j]; i2 = j; } }
#undef LOGIT
            const float p1 = 1.0f / (1.0f + __expf(v2 - v1)), p2 = 1.0f - p1;
            rstdv = rstd;
            e1 = 8 * g + i1; e2 = 8 * g + i2; g1 = pg * p1; g2 = pg * p2;
            k1 = __hip_atomic_fetch_add(&hist[e1], 1u, __ATOMIC_RELAXED, __HIP_MEMORY_SCOPE_WORKGROUP); k2 = __hip_atomic_fetch_add(&hist[e2], 1u, __ATOMIC_RELAXED, __HIP_MEMORY_SCOPE_WORKGROUP);
        }
        LDS_WAIT(); __syncthreads();
        if (F.tid < 64) { const unsigned n = hist[F.tid]; hbase[F.tid] = n ? atomicAdd(&CNT[F.tid * CNT_STRIDE], n) : 0u; }
        LDS_WAIT(); __syncthreads();
        if (F.tid < 64) { const int tk = tg * 64 + F.tid;
            const unsigned sl1 = (unsigned)e1 * CAP + hbase[e1] + k1, sl2 = (unsigned)e2 * CAP + hbase[e2] + k2;
            ROWTOK[sl1] = (unsigned)tk; ROWGATE[sl1] = g1; ROWRSTD[sl1] = rstdv; ROWTOK[sl2] = (unsigned)tk; ROWGATE[sl2] = g2; ROWRSTD[sl2] = rstdv;
            TOKPOS[2 * tk] = sl1; TOKPOS[2 * tk + 1] = sl2;
        }
        __syncthreads();
    }
}

__device__ __forceinline__ void p7_combine(Frame& F, const LAS int* tab) {
    int lane7 = F.lane; asm volatile("" : "+v"(lane7));
    const unsigned* TOKPOS = (const unsigned*)(F.ws + WS_TOKPOS); const bf16* YB = (const bf16*)(F.wsh + WS_YB);
    const int gw = F.vcu * 8 + F.wave, NGW = F.G * 8;
    for (int m = gw; m < T; m += NGW) {
        const unsigned s1 = TOKPOS[2 * m], s2 = TOKPOS[2 * m + 1];
        const size_t h1 = (size_t)tab[259 + (s1 >> 15)] + (s1 & 32767u), h2 = (size_t)tab[259 + (s2 >> 15)] + (s2 & 32767u);
        const GAS u32x2* x1 = (const GAS u32x2*)((const bf16*)(F.wsh + WS_XG) + (size_t)m * DM) + lane7; GAS f32x4* od = (GAS f32x4*)(F.out + (size_t)m * DM) + lane7;
        const GAS u32x2* y1 = (const GAS u32x2*)(YB + h1 * DM) + lane7; const GAS u32x2* y2 = (const GAS u32x2*)(YB + h2 * DM) + lane7;
#pragma unroll
        for (int j = 0; j < 4; ++j) { const u32x2 xx = __builtin_nontemporal_load(&x1[64 * j]), a = __builtin_nontemporal_load(&y1[64 * j]), b = __builtin_nontemporal_load(&y2[64 * j]); f32x4 v;
            v[0] = bflo(xx.x) + (bflo(a.x) + bflo(b.x)); v[1] = bfhi(xx.x) + (bfhi(a.x) + bfhi(b.x)); v[2] = bflo(xx.y) + (bflo(a.y) + bflo(b.y)); v[3] = bfhi(xx.y) + (bfhi(a.y) + bfhi(b.y)); __builtin_nontemporal_store(v, &od[64 * j]); }
    }
}

__global__ void __launch_bounds__(512, 2) fwd_kernel(Args args) {
    extern __shared__ __attribute__((aligned(16))) unsigned char lds[];
    Frame F;
    F.lds = (LAS unsigned char*)lds; F.tid = threadIdx.x; F.lane = F.tid & 63; F.wave = __builtin_amdgcn_readfirstlane(F.tid >> 6);
    F.G = gridDim.x; { const int bx = blockIdx.x; F.vcu = (F.G % 8 == 0) ? (bx % 8) * (F.G / 8) + bx / 8 : bx; }
#pragma unroll
    for (int i = 0; i < 21; ++i) F.in[i] = args.in[i];
    F.out = args.out; F.ws = args.ws; F.wsh = args.wsh;
    volatile LAS unsigned* MISC = (volatile LAS unsigned*)(F.lds + MISC_OFF);
    for (int u = F.tid; u < (LDS_BYTES - LDSCTL_OFF) / 4; u += 512) ((LAS unsigned*)(F.lds + LDSCTL_OFF))[u] = 0u;
    __syncthreads();
    unsigned* ctl = (unsigned*)(F.ws + WS_CTL);
    XcdBarrier bar = xcd_barrier_post(ctl + CW_BAR, MISC + 8);
    const int lo = args.ph_lo, hi = args.ph_hi;
#define IN(k) (lo <= (k) && (k) < hi)
#define SEAM(k) do { if (IN(k) && IN((k) + 1)) xcd_barrier(bar); } while (0)
    LAS int* tab = (LAS int*)(F.lds + TAB_OFF);

    p0_prologue<0>(F);
    { const XbTicket t01 = xcd_barrier_arrive(bar); p0_prologue<1>(F); xcd_barrier_wait(bar, t01); }
    if (IN(1)) {
        pg8::Gemm g{(const bf16*)(F.wsh + WS_XB), (const bf16*)(F.ws + WS_WIN), DM}; pg8::StaticOrder S; S.init(T, INW, F.G, (int)blockIdx.x);
        LAS float* gz = (LAS float*)(F.lds + GZ_OFF);
        if (F.tid < 192) gz[F.tid] = F.tid < 64 ? F.in[4][F.tid] * C2 : (F.tid < 128 ? F.in[5][F.tid - 64] : F.in[10][F.tid - 128] * C2);
        LDS_WAIT(); __syncthreads();
        pg8::EpiZ E{(bf16*)(F.wsh + WS_Z), (const float*)(F.ws + WS_RS), gz};
        pg8::gemm_phase<pg8::EpiZ, pg8::StaticOrder, false, false>(F.lds, g, S, E);
    }
    { const XbTicket t12 = xcd_barrier_arrive(bar); p0_prologue<2>(F); LDS_WAIT(); xcd_barrier_wait(bar, t12); }
    if (IN(2)) { p2_attention(F); }
    { const XbTicket t23 = xcd_barrier_arrive(bar); p0_prologue<3>(F); xcd_barrier_wait(bar, t23); }
    if (IN(3)) {
        pg8::Gemm g{(const bf16*)(F.wsh + WS_MIX), (const bf16*)(F.ws + WS_WOUT), DM}; pg8::StaticOrder S; S.init(T, DM, F.G, (int)blockIdx.x);
        pg8::EpiX1 E{(const bf16*)(F.wsh + WS_XB), (bf16*)(F.wsh + WS_XG), (float*)(F.ws + WS_SSQ)};
        pg8::gemm_phase<pg8::EpiX1, pg8::StaticOrder, false, false>(F.lds, g, S, E);
    }
    const XbTicket t34 = xcd_barrier_arrive(bar);
    expert_convert<0>(F);
    LDS_WAIT();
    xcd_barrier_wait(bar, t34);
    p4_router(F);
    const XbTicket t45 = xcd_barrier_arrive(bar);
    expert_convert<1>(F);
    LDS_WAIT();
    xcd_barrier_wait(bar, t45);
    if (IN(5) || IN(6) || IN(7)) {
        if (F.tid < 64) { const int c = (int)__hip_atomic_load(ctl + CW_CNT + F.tid * CNT_STRIDE, RLX_AGENT); const int ntl = (c + 255) >> 8;
            const int lt = (ntl > 0 && c - (ntl - 1) * 256 <= 128) ? 1 : 0; int i0 = ntl, i1 = ntl - lt, i2 = lt, i3 = c;
#pragma unroll
            for (int o = 1; o < 64; o <<= 1) { const int v0 = __shfl_up(i0, o), v1 = __shfl_up(i1, o), v2 = __shfl_up(i2, o), v3 = __shfl_up(i3, o); if (F.lane >= o) { i0 += v0; i1 += v1; i2 += v2; i3 += v3; } }
            tab[F.tid] = c; tab[64 + F.tid + 1] = i0; tab[129 + F.tid + 1] = i1; tab[194 + F.tid + 1] = i2; tab[259 + F.tid + 1] = i3; if (F.tid == 0) { tab[64] = 0; tab[129] = 0; tab[194] = 0; tab[259] = 0; } }
        LDS_WAIT(); __syncthreads();
    }
    if (IN(5)) {
        pg8::Gemm g{(const bf16*)(F.wsh + WS_X1Q), (const bf16*)(F.wsh + WS_W13), DM / 2};
        pg8::GroupOrder S{tab, (const unsigned*)(F.ws + WS_ROWTOK), F.G, (int)blockIdx.x};
        pg8::EpiH E{F.wsh + WS_HMID, (const float*)(F.ws + WS_ROWRSTD)};
        pg8::gemm_phase<pg8::EpiH, pg8::GroupOrder, true, true>(F.lds, g, S, E);
    }
    SEAM(5);
    if (IN(6)) {
        pg8::Gemm g{(const bf16*)(F.wsh + WS_HMID), (const bf16*)(F.wsh + WS_W2), EH / 2};
        pg8::GroupOrder S{tab, (const unsigned*)(F.ws + WS_ROWTOK), F.G, (int)blockIdx.x};
        pg8::EpiY E{(bf16*)(F.wsh + WS_YB), (const float*)(F.ws + WS_ROWGATE), tab};
        pg8::gemm_phase<pg8::EpiY, pg8::GroupOrder, false, true>(F.lds, g, S, E);
    }
    SEAM(6);
    if (IN(7)) { p7_combine(F, tab); }
#undef IN
#undef SEAM
}

extern "C" void kernel_launch(void* const* d_in, const int* in_sizes, int n_in, void* d_out, int out_size, void* d_ws, size_t ws_size, hipStream_t stream) {
    static int grid = 0;
    if (grid == 0) {
        if (n_in != 21 || out_size != T * DM || ws_size < WS_END) { fprintf(stderr, "kernel_launch: unexpected shapes (n_in %d out %d ws %zu)\n", n_in, out_size, ws_size); grid = -1; return; }
        int dev = 0, cus = 0, per_cu = 0;
        if (hipGetDevice(&dev) != hipSuccess || hipDeviceGetAttribute(&cus, hipDeviceAttributeMultiprocessorCount, dev) != hipSuccess) { grid = -1; return; }
        if (hipFuncSetAttribute((const void*)fwd_kernel, hipFuncAttributeMaxDynamicSharedMemorySize, LDS_BYTES) != hipSuccess) { fprintf(stderr, "kernel_launch: hipFuncSetAttribute failed\n"); grid = -1; return; }
        if (hipOccupancyMaxActiveBlocksPerMultiprocessor(&per_cu, (const void*)fwd_kernel, 512, LDS_BYTES) != hipSuccess || per_cu < 1) { fprintf(stderr, "kernel_launch: occupancy query says %d\n", per_cu); }
        (void)hipGetLastError();
        grid = cus;
    }
    if (grid < 0) return;
    if (hipMemsetAsync((char*)d_ws + WS_CTL, 0, CTL_ZERO_BYTES, stream) != hipSuccess) return;
    Args a{};
    for (int i = 0; i < 21; ++i) a.in[i] = (const float*)d_in[i];
    a.out = (float*)d_out; a.ws = (unsigned char*)d_ws; a.wsh = (unsigned char*)d_ws + (((ws_size >> 20) << 20) - WS_END); a.ph_lo = 0; a.ph_hi = 8;
    hipLaunchKernelGGL(fwd_kernel, dim3(grid), dim3(512), LDS_BYTES, stream, a);
}
```

```cpp
#include <hip/hip_runtime.h>
#include <cstdio>
#include <cstdint>

#define LAS __attribute__((address_space(3)))
#define GAS __attribute__((address_space(1)))
typedef unsigned short bf16;
typedef short bf16x8 __attribute__((ext_vector_type(8)));
typedef short s16x4 __attribute__((ext_vector_type(4)));
typedef float f32x4 __attribute__((ext_vector_type(4)));
typedef float f32x16 __attribute__((ext_vector_type(16)));
typedef float f32x2 __attribute__((ext_vector_type(2)));
typedef __bf16 bf16x2_t __attribute__((ext_vector_type(2)));
typedef unsigned u32x4 __attribute__((ext_vector_type(4)));
typedef unsigned u32x2 __attribute__((ext_vector_type(2)));
typedef GAS unsigned gu32;
typedef int v4i __attribute__((ext_vector_type(4)));
typedef int v8i __attribute__((ext_vector_type(8)));

constexpr int BATCH = 4, SEQ = 4096, DM = 1024, T = BATCH * SEQ;
constexpr int INW = 2048, NMEM = 256;
constexpr int NEXP = 64, EH = 512, CAP = 32768;
constexpr float EPS = 1e-6f;
constexpr float W13_SCALE = 64.f, W2_SCALE = 32.f, H_SCALE = 4.f, F8MAX = 448.f;
constexpr float C2 = 0.125f * 1.4426950408889634f;
constexpr int ZQ = 0, ZK = 512, ZV = 1024, ZU = 1536, ZQM = 1792;

constexpr size_t MiB = 1u << 20;
constexpr size_t WS_CTL = 0, CTL_ZERO_BYTES = 1 * MiB;
constexpr size_t WS_RS = 1 * MiB;
constexpr size_t WS_RSTD = 1 * MiB + 128 * 1024;
constexpr size_t WS_SSQ = 2 * MiB;
constexpr size_t WS_WIN = 4 * MiB;
constexpr size_t WS_WOUT = 8 * MiB;
constexpr size_t WS_RT = 10 * MiB;
constexpr size_t WS_KVM = 11 * MiB;
constexpr size_t WS_TOKPOS = 12 * MiB;
constexpr size_t WS_ROWTOK = 13 * MiB;
constexpr size_t WS_ROWGATE = 21 * MiB;
constexpr size_t WS_LP = 29 * MiB;
constexpr size_t WS_ROWRSTD = 50 * MiB;
constexpr size_t WS_XB = 480 * MiB;
constexpr size_t WS_XG = 480 * MiB;
constexpr size_t WS_Z = 416 * MiB;
constexpr size_t WS_W13 = 416 * MiB;
constexpr size_t WS_YB = 416 * MiB;
constexpr size_t WS_MIX = 384 * MiB;
constexpr size_t WS_W2 = 304 * MiB;
constexpr size_t WS_PO = 336 * MiB;
constexpr size_t WS_X1Q = 336 * MiB;
constexpr size_t WS_HMID = 356 * MiB;
constexpr size_t WS_END = 512 * MiB;
constexpr int CW_CNT = 16384, CNT_STRIDE = 64;
constexpr int CW_BAR = 4096;

constexpr int RING_BYTES = 131072;
constexpr int WSCR_OFF = RING_BYTES;
constexpr int TAB_OFF = WSCR_OFF + 2048;
constexpr int LDSCTL_OFF = TAB_OFF + 2048, MISC_OFF = LDSCTL_OFF;
constexpr int RSC_OFF = LDSCTL_OFF + 1024;
constexpr int LDS_BYTES = 147456;
constexpr int RTK_OFF = RSC_OFF + 3072;
constexpr int GZ_OFF = RTK_OFF + 2048;
static_assert(GZ_OFF + 768 <= LDS_BYTES, "LDS map");

#define RLX_AGENT __ATOMIC_RELAXED, __HIP_MEMORY_SCOPE_AGENT
#define LDS_WAIT() asm volatile("s_waitcnt lgkmcnt(0)" ::: "memory")
#define VM_WAIT() asm volatile("s_waitcnt vmcnt(0)" ::: "memory")
__device__ __forceinline__ unsigned f2bf(float f) { unsigned u = __builtin_bit_cast(unsigned, f); return (u + 0x7fffu + ((u >> 16) & 1u)) >> 16; }
__device__ __forceinline__ unsigned pk2(float lo, float hi) { f32x2 v = {lo, hi}; bf16x2_t b = __builtin_convertvector(v, bf16x2_t); return __builtin_bit_cast(unsigned, b); }
__device__ __forceinline__ unsigned pk4f8(float a, float b, float c, float d) {
    a = __builtin_amdgcn_fmed3f(a, -F8MAX, F8MAX); b = __builtin_amdgcn_fmed3f(b, -F8MAX, F8MAX); c = __builtin_amdgcn_fmed3f(c, -F8MAX, F8MAX); d = __builtin_amdgcn_fmed3f(d, -F8MAX, F8MAX);
    int w = 0; w = __builtin_amdgcn_cvt_pk_fp8_f32(a, b, w, false); w = __builtin_amdgcn_cvt_pk_fp8_f32(c, d, w, true); return (unsigned)w; }
__device__ __forceinline__ v8i cat8(bf16x8 a, bf16x8 b) { const v4i x = __builtin_bit_cast(v4i, a), y = __builtin_bit_cast(v4i, b); return __builtin_shufflevector(x, y, 0, 1, 2, 3, 4, 5, 6, 7); }
__device__ __forceinline__ float bf2f(unsigned short h) { return __builtin_bit_cast(float, (unsigned)h << 16); }
__device__ __forceinline__ float bflo(unsigned w) { return __builtin_bit_cast(float, w << 16); }
__device__ __forceinline__ float bfhi(unsigned w) { return __builtin_bit_cast(float, w & 0xffff0000u); }
__device__ __forceinline__ float wave_sum(float v) {
#pragma unroll
    for (int o = 1; o < 64; o <<= 1) v += __shfl_xor(v, o);
    return v;
}
__device__ __forceinline__ int crow(int r, int hi) { return (r & 3) + 8 * (r >> 2) + 4 * hi; }

namespace pg8 {
constexpr int BM = 256, BK = 64, HALF = 128, HTB = HALF * BK * 2, NXCD = 8, WGM = 8;
__host__ __device__ __forceinline__ int lds_byte(int r, int c) { const int st = (r >> 4) * 2 + (c >> 5), rr = r & 15, cc = c & 31, ob = rr * 64 + cc * 2; return st * 1024 + (ob ^ (((ob >> 9) & 1) << 5)); }
__host__ __device__ __forceinline__ void stage_rc(int b, int& R, int& C) { const int st = b / 1024, sb = b % 1024, swz = sb ^ (((sb >> 9) & 1) << 5); R = (st >> 1) * 16 + swz / 64; C = (st & 1) * 32 + (swz % 64) / 2; }
__host__ __device__ __forceinline__ int perm32(int rho) { const int n = rho >> 4, i = rho & 15; return 8 * (i >> 2) + 4 * n + (i & 3); }

struct Unit { int pm, pn, e, mt, cnt, light; };
struct Gemm { const bf16* A; const bf16* Bt; int K; };

struct StaticOrder {
    int nM, nN, nwg, G, c;
    __device__ void init(int M, int N, int G_, int c_) { nM = M / BM; nN = N / BM; nwg = nM * nN; G = G_; c = c_; }
    __device__ bool next(int i, Unit& u) const {
        const long L = (long)i * G + c; if (L >= nwg) return false;
        int wgid = (int)L; { const int q = nwg / NXCD, r = nwg % NXCD, xcd = wgid % NXCD, off = wgid / NXCD; wgid = (xcd < r ? xcd * (q + 1) : r * (q + 1) + (xcd - r) * q) + off; }
        const int nig = WGM * nN, gid = wgid / nig, fm = gid * WGM, gsz = (nM - fm) < WGM ? (nM - fm) : WGM;
        u.pm = fm + ((wgid % nig) % gsz); u.pn = (wgid % nig) / gsz; u.e = 0; u.mt = 0; u.cnt = 0; u.light = 0; return true;
    }
    __device__ __forceinline__ int row(const Unit&, int) const { return 0; }
    __device__ __forceinline__ int row_lds(const Unit&, int, const LAS unsigned*) const { return 0; }
    __device__ __forceinline__ const unsigned* rtk_src(const Unit&) const { return nullptr; }
};
struct GroupOrder {
    const LAS int* tab;
    const unsigned* rowtok;
    int G, c;
    __device__ bool next(int i, Unit& u) const {
        const int NUH = tab[129 + 64] * 4, NUL = tab[194 + 64] * 4; long L = (long)i * G + c; if (L >= NUH + NUL) return false;
        const int lt = L >= NUH; const int NU = lt ? NUL : NUH; int wgid = (int)(lt ? L - NUH : L);
        { const int q = NU / NXCD, r = NU % NXCD, xcd = wgid % NXCD, off = wgid / NXCD; wgid = (xcd < r ? xcd * (q + 1) : r * (q + 1) + (xcd - r) * q) + off; }
        const int xt = wgid >> 2, pnl = wgid & 3, base = lt ? 194 : 129; int lo = 0;
#pragma unroll
        for (int st = 32; st >= 1; st >>= 1) { if (tab[base + lo + st] <= xt) lo += st; }
        const int ts = tab[64 + lo], ntl = tab[64 + lo + 1] - ts, mt = lt ? ntl - 1 : xt - tab[129 + lo];
        u.pm = ts + mt; u.pn = lo * 4 + pnl; u.e = lo; u.mt = mt; u.cnt = tab[lo]; u.light = lt; return true;
    }
    __device__ __forceinline__ int row(const Unit& u, int rl) const { const int idx = u.mt * 256 + rl; return idx < u.cnt ? (int)rowtok[(size_t)u.e * CAP + idx] : T; }
    __device__ __forceinline__ int row_lds(const Unit& u, int rl, const LAS unsigned* rt) const { const int idx = u.mt * 256 + rl; const int v = (int)rt[rl]; return idx < u.cnt ? v : T; }
    __device__ __forceinline__ const unsigned* rtk_src(const Unit& u) const { return rowtok + (size_t)u.e * CAP + u.mt * 256; }
};

template <class Epi, class Sched, bool GATHER, bool F8>
__device__ __forceinline__ void gemm_phase(LAS unsigned char* lds, const Gemm g, const Sched& S, const Epi& E) {
    const int tid = threadIdx.x, wid = __builtin_amdgcn_readfirstlane(tid >> 6), lane = tid & 63, wr = wid >> 2, wc = wid & 3, fr = lane & 15, fq = lane >> 4;
    const int K = g.K, nt = K / BK;
    unsigned voffA[2], voffB[2]; int RA[2], CA[2];
#pragma unroll
    for (int i = 0; i < 2; ++i) { int R, C; stage_rc(tid * 16 + i * 8192, R, C); const int Rb = Epi::PERM ? ((R & ~31) + perm32(R & 31)) : R;
        voffA[i] = (unsigned)(R * K + C) * 2u; voffB[i] = (unsigned)(Rb * K + C) * 2u; RA[i] = R; CA[i] = C; }
    const size_t kstep = (size_t)(BK * 2);
    const size_t hstep = (size_t)HALF * K * 2;
    const size_t tstep = 2 * hstep;
    const unsigned ldsw = (unsigned)wid * 1024u;
    const int aoff = lds_byte(wr * 64 + fr, fq * 8), boff = lds_byte(wc * 32 + fr, fq * 8);
    const char* gAb = (const char*)g.A;
    unsigned goff[2][2];
#define PG8_SA(b, h) (((b) * 2 + (h)) * HTB)
#define PG8_SB(b, h) ((4 + (b) * 2 + (h)) * HTB)
#define PG8_STAGE(bufoff, gbase, voff) do { _Pragma("unroll") for (int _i = 0; _i < 2; ++_i) \
        __builtin_amdgcn_global_load_lds((const unsigned*)((const char*)(gbase) + (voff)[_i]), (LAS unsigned*)(lds + (bufoff) + ldsw + _i * 8192), 16, 0, 0); } while (0)
#define PG8_STAGE_A(bufoff, h, base, kb) do { if constexpr (GATHER) { PG8_STAGE(bufoff, gAb + (kb), goff[h]); } else { PG8_STAGE(bufoff, (base) + (size_t)(h) * hstep + (kb), voffA); } } while (0)
#define PG8_SETG(u) do { if constexpr (GATHER) { _Pragma("unroll") for (int _h = 0; _h < 2; ++_h) _Pragma("unroll") for (int _i = 0; _i < 2; ++_i) \
        goff[_h][_i] = ((unsigned)S.row(u, _h * HALF + RA[_i]) * (unsigned)K + (unsigned)CA[_i]) * 2u; } } while (0)
#define PG8_SETG_LDS(u, slot) do { if constexpr (GATHER) { const LAS unsigned* rt_ = (const LAS unsigned*)(lds + RTK_OFF + (slot) * 1024); _Pragma("unroll") for (int _h = 0; _h < 2; ++_h) _Pragma("unroll") for (int _i = 0; _i < 2; ++_i) \
        goff[_h][_i] = ((unsigned)S.row_lds(u, _h * HALF + RA[_i], rt_) * (unsigned)K + (unsigned)CA[_i]) * 2u; } } while (0)
#define PG8_RTK(u, slot) do { if constexpr (GATHER) { if (wid == 1) { const unsigned* rp_ = S.rtk_src(u); unsigned keep_; const unsigned dst_ = (unsigned)(uintptr_t)(lds + RTK_OFF + (slot) * 1024); \
        asm volatile("s_mov_b32 %0, m0\n\ts_mov_b32 m0, %2\n\ts_nop 0\n\tglobal_load_lds_dwordx4 %1, off\n\ts_mov_b32 m0, %0" : "=&s"(keep_) : "v"(rp_ + lane * 4), "s"(dst_) : "memory"); } } } while (0)
#define PG8_LDA(dst, b, h) do { _Pragma("unroll") for (int m = 0; m < 4; ++m) dst[m] = cat8(*(const LAS bf16x8*)(lds + PG8_SA(b, h) + aoff + m * 2048), *(const LAS bf16x8*)(lds + PG8_SA(b, h) + aoff + m * 2048 + 1024)); } while (0)
#define PG8_LDB(dst, b, h) do { _Pragma("unroll") for (int n = 0; n < 2; ++n) dst[n] = cat8(*(const LAS bf16x8*)(lds + PG8_SB(b, h) + boff + n * 2048), *(const LAS bf16x8*)(lds + PG8_SB(b, h) + boff + n * 2048 + 1024)); } while (0)
#define PG8_LO(x) __builtin_bit_cast(bf16x8, __builtin_shufflevector(x, x, 0, 1, 2, 3))
#define PG8_HI(x) __builtin_bit_cast(bf16x8, __builtin_shufflevector(x, x, 4, 5, 6, 7))
#define PG8_MMA(ai, bj, At, Bt) do { __builtin_amdgcn_s_setprio(1); _Pragma("unroll") for (int m = 0; m < 4; ++m) _Pragma("unroll") for (int n = 0; n < 2; ++n) { \
        if constexpr (F8) asm volatile("v_mfma_f32_16x16x128_f8f6f4 %0, %1, %2, %0" : "+v"(acc[ai][bj][m][n]) : "v"(Bt[n]), "v"(At[m])); \
        else { acc[ai][bj][m][n] = __builtin_amdgcn_mfma_f32_16x16x32_bf16(PG8_LO(Bt[n]), PG8_LO(At[m]), acc[ai][bj][m][n], 0, 0, 0); \
               acc[ai][bj][m][n] = __builtin_amdgcn_mfma_f32_16x16x32_bf16(PG8_HI(Bt[n]), PG8_HI(At[m]), acc[ai][bj][m][n], 0, 0, 0); } } __builtin_amdgcn_s_setprio(0); } while (0)
#define PG8_WAIT_V(n) asm volatile("s_waitcnt vmcnt(" #n ")" ::: "memory")
#define PG8_WAIT_L(n) asm volatile("s_waitcnt lgkmcnt(" #n ")" ::: "memory")
#define PG8_BAR __builtin_amdgcn_s_barrier()
#define PG8_SCHED __builtin_amdgcn_sched_barrier(0)
    Unit cur, nxt; int ui = 0;
    if (!S.next(0, cur)) return;
#define PG8_RSC(u, slot) do { if (wid == 0) { const float* rp_ = E.rsc_src(u); if (rp_) { unsigned keep_; const unsigned dst_ = (unsigned)(uintptr_t)(lds + RSC_OFF + (slot) * 1024); \
        asm volatile("s_mov_b32 %0, m0\n\ts_mov_b32 m0, %2\n\ts_nop 0\n\tglobal_load_lds_dwordx4 %1, off\n\ts_mov_b32 m0, %0" : "=&s"(keep_) : "v"(rp_ + lane * 4), "s"(dst_) : "memory"); } } } while (0)
    PG8_RSC(cur, 0);
    f32x4 acc[2][2][4][2];
#pragma unroll
    for (int a = 0; a < 2; ++a)
#pragma unroll
        for (int b = 0; b < 2; ++b)
#pragma unroll
            for (int m = 0; m < 4; ++m)
#pragma unroll
                for (int n = 0; n < 2; ++n) acc[a][b][m][n] = (f32x4){0.f, 0.f, 0.f, 0.f};
    v8i At[4], B0[2], B1[2];
    const char* cA = (const char*)g.A + (size_t)cur.pm * tstep; const char* cB = (const char*)g.Bt + (size_t)cur.pn * tstep;
    PG8_SETG(cur);
    PG8_STAGE(PG8_SB(0, 0), cB, voffB); PG8_STAGE(PG8_SB(0, 1), cB + hstep, voffB); PG8_STAGE_A(PG8_SA(0, 0), 0, cA, 0); PG8_STAGE_A(PG8_SA(0, 1), 1, cA, 0);
    if (wr == 1) PG8_BAR;
    PG8_WAIT_V(2); PG8_BAR;
    PG8_STAGE(PG8_SB(1, 0), cB + kstep, voffB); PG8_STAGE_A(PG8_SA(1, 0), 0, cA, kstep); PG8_STAGE(PG8_SB(1, 1), cB + hstep + kstep, voffB);
    PG8_WAIT_V(6); PG8_BAR;
    for (;;) {
        const bool has_next = S.next(ui + 1, nxt);
        if (has_next) { PG8_RSC(nxt, (ui + 1) % 3); PG8_RTK(nxt, (ui + 1) & 1); }
        const char* nA = has_next ? (const char*)g.A + (size_t)nxt.pm * tstep : cA; const char* nB = has_next ? (const char*)g.Bt + (size_t)nxt.pn * tstep : cB;
#pragma unroll 1
        for (int t = 0; t < nt; t += 2) {
            const bool last = (t == nt - 2);
            const size_t k1 = (size_t)(t + 1) * kstep, k2 = last ? 0 : (size_t)(t + 2) * kstep, k3 = k2 + kstep;
            const char* pa2 = last ? nA : cA; const char* pb2 = last ? nB : cB;
            PG8_LDB(B0, 0, 0); PG8_LDB(B1, 0, 1); PG8_SCHED; PG8_LDA(At, 0, 0); PG8_STAGE_A(PG8_SA(1, 1), 1, cA, k1);
            if constexpr (GATHER) { if (last && has_next) PG8_SETG_LDS(nxt, (ui + 1) & 1); }
            PG8_WAIT_V(8); PG8_WAIT_L(0); PG8_BAR; PG8_MMA(0, 0, At, B0); PG8_MMA(0, 1, At, B1); PG8_BAR; PG8_SCHED;
            if (!cur.light) PG8_LDA(At, 0, 1); PG8_STAGE(PG8_SB(0, 0), pb2 + k2, voffB); PG8_STAGE(PG8_SB(0, 1), pb2 + hstep + k2, voffB); PG8_STAGE_A(PG8_SA(0, 0), 0, pa2, k2);
            PG8_WAIT_V(8); PG8_WAIT_L(0); PG8_BAR; if (!cur.light) { PG8_MMA(1, 0, At, B0); PG8_MMA(1, 1, At, B1); } PG8_BAR; PG8_SCHED;
            PG8_LDB(B0, 1, 0); PG8_LDB(B1, 1, 1); PG8_SCHED; PG8_LDA(At, 1, 0); PG8_STAGE_A(PG8_SA(0, 1), 1, pa2, k2);
            PG8_WAIT_V(8); PG8_WAIT_L(0); PG8_BAR; PG8_MMA(0, 0, At, B0); PG8_MMA(0, 1, At, B1); PG8_BAR; PG8_SCHED;
            if (!cur.light) PG8_LDA(At, 1, 1); PG8_STAGE(PG8_SB(1, 0), pb2 + k3, voffB); PG8_STAGE(PG8_SB(1, 1), pb2 + hstep + k3, voffB); PG8_STAGE_A(PG8_SA(1, 0), 0, pa2, k3);
            PG8_WAIT_V(8); PG8_WAIT_L(0); PG8_BAR; if (!cur.light) { PG8_MMA(1, 0, At, B0); PG8_MMA(1, 1, At, B1); } PG8_BAR; PG8_SCHED;
        }
        if constexpr (F8) { asm volatile("s_nop 15\n\ts_nop 15" ::: "memory"); PG8_SCHED; }
        if (wr == 0) PG8_BAR;
        E(acc, cur, wr, wc, fr, fq, (const LAS float*)(lds + RSC_OFF + (ui % 3) * 1024));
        if (!has_next) break;
#pragma unroll
        for (int a = 0; a < 2; ++a)
#pragma unroll
            for (int b = 0; b < 2; ++b)
#pragma unroll
                for (int m = 0; m < 4; ++m)
#pragma unroll
                    for (int n = 0; n < 2; ++n) acc[a][b][m][n] = (f32x4){0.f, 0.f, 0.f, 0.f};
        cur = nxt; cA = nA; cB = nB; ++ui;
        if (wr == 1) PG8_BAR;
    }
    PG8_WAIT_V(0);
    PG8_BAR;
#undef PG8_SA
#undef PG8_SB
#undef PG8_STAGE
#undef PG8_STAGE_A
#undef PG8_SETG
#undef PG8_SETG_LDS
#undef PG8_RTK
#undef PG8_LDA
#undef PG8_LDB
#undef PG8_RSC
#undef PG8_LO
#undef PG8_HI
#undef PG8_MMA
#undef PG8_WAIT_V
#undef PG8_WAIT_L
#undef PG8_BAR
#undef PG8_SCHED
}

struct EpiZ {
    static constexpr bool PERM = true;
    bf16* Z; const float* rs; const LAS float* gz;
    __device__ __forceinline__ const float* rsc_src(const Unit& u) const { return rs + (size_t)u.pm * BM; }
    __device__ __forceinline__ void operator()(const f32x4 (&acc)[2][2][4][2], const Unit& u, int wr, int wc, int fr, int fq, const LAS float* rsc) const {
        const int pn = u.pn;
        const LAS float* gp = pn < 2 ? gz : (pn < 4 ? gz + 64 : (pn == 7 ? gz + 128 : nullptr));
        f32x4 gv[2][2];
#pragma unroll
        for (int bj = 0; bj < 2; ++bj)
#pragma unroll
            for (int n = 0; n < 2; ++n) gv[bj][n] = gp ? *(const LAS f32x4*)(gp + 32 * bj + 8 * fq + 4 * n) : (f32x4){1.f, 1.f, 1.f, 1.f};
        const int col0 = 256 * pn + 64 * wc + 8 * fq;
#pragma unroll
        for (int ai = 0; ai < 2; ++ai)
#pragma unroll
            for (int m = 0; m < 4; ++m) {
                const int rl = ai * HALF + wr * 64 + m * 16 + fr, row = u.pm * BM + rl; const float r = rsc[rl];
                f32x4 v[2][2]; float ss = 0.f;
#pragma unroll
                for (int bj = 0; bj < 2; ++bj)
#pragma unroll
                    for (int n = 0; n < 2; ++n) { v[bj][n] = acc[ai][bj][m][n] * r; const f32x4 q = v[bj][n] * v[bj][n]; ss += (q[0] + q[1]) + (q[2] + q[3]); }
                if (gp) { ss += __shfl_xor(ss, 16); ss += __shfl_xor(ss, 32); const float rn = 1.0f / sqrtf(ss * (1.f / 64.f) + EPS);
#pragma unroll
                    for (int bj = 0; bj < 2; ++bj)
#pragma unroll
                        for (int n = 0; n < 2; ++n) v[bj][n] = v[bj][n] * rn * gv[bj][n]; }
                bf16* rowp = Z + ((size_t)(4 * pn + wc) * T + row) * 64 + 8 * fq;
#pragma unroll
                for (int bj = 0; bj < 2; ++bj) { u32x4 w; w.x = pk2(v[bj][0][0], v[bj][0][1]); w.y = pk2(v[bj][0][2], v[bj][0][3]); w.z = pk2(v[bj][1][0], v[bj][1][1]); w.w = pk2(v[bj][1][2], v[bj][1][3]);
                    *(u32x4*)(rowp + 32 * bj) = w; }
            }
    }
};
struct EpiX1 {
    static constexpr bool PERM = true;
    const bf16* xb; bf16* x1b; float* ssq;
    __device__ __forceinline__ const float* rsc_src(const Unit&) const { return nullptr; }
    __device__ __forceinline__ void operator()(const f32x4 (&acc)[2][2][4][2], const Unit& u, int wr, int wc, int fr, int fq, const LAS float*) const {
        const int col0 = u.pn * BM + wc * 32 + 8 * fq;
#pragma unroll
        for (int ai = 0; ai < 2; ++ai)
#pragma unroll
            for (int m = 0; m < 4; ++m) {
                const int row = u.pm * BM + ai * HALF + wr * 64 + m * 16 + fr; const size_t off = (size_t)row * DM + col0; float ss = 0.f;
#pragma unroll
                for (int bj = 0; bj < 2; ++bj) { f32x4 x1[2]; const u32x4 xw = *(const u32x4*)(xb + off + bj * HALF);
                    x1[0] = (f32x4){bflo(xw.x), bfhi(xw.x), bflo(xw.y), bfhi(xw.y)} + acc[ai][bj][m][0]; x1[1] = (f32x4){bflo(xw.z), bfhi(xw.z), bflo(xw.w), bfhi(xw.w)} + acc[ai][bj][m][1];
#pragma unroll
                    for (int n = 0; n < 2; ++n) { const f32x4 q = x1[n] * x1[n]; ss += (q[0] + q[1]) + (q[2] + q[3]); }
                    u32x4 w; w.x = pk2(x1[0][0], x1[0][1]); w.y = pk2(x1[0][2], x1[0][3]); w.z = pk2(x1[1][0], x1[1][1]); w.w = pk2(x1[1][2], x1[1][3]);
                    *(u32x4*)(x1b + off + bj * HALF) = w; }
                ss += __shfl_xor(ss, 16); ss += __shfl_xor(ss, 32);
                if (fq == 0) ssq[(size_t)row * 16 + u.pn * 4 + wc] = ss;
            }
    }
};
struct EpiH {
    static constexpr bool PERM = true;
    unsigned char* H; const float* rowrstd;
    __device__ __forceinline__ const float* rsc_src(const Unit& u) const { return rowrstd + (size_t)u.e * CAP + u.mt * 256; }
    __device__ __forceinline__ void operator()(const f32x4 (&acc)[2][2][4][2], const Unit& u, int wr, int wc, int fr, int fq, const LAS float* rsc) const {
        const int pnl = u.pn & 3, col0 = 128 * pnl + 32 * wc + 8 * fq;
#pragma unroll
        for (int ai = 0; ai < 2; ++ai) { if (ai == 1 && u.light) break;
#pragma unroll
            for (int m = 0; m < 4; ++m) {
                const int rl = ai * HALF + wr * 64 + m * 16 + fr, idx = u.mt * 256 + rl; const bool valid = idx < u.cnt;
                const float rs = valid ? rsc[rl] * (1.0f / W13_SCALE) : 0.f;
                float h[8];
#pragma unroll
                for (int n = 0; n < 2; ++n)
#pragma unroll
                    for (int e = 0; e < 4; ++e) { const float a = acc[ai][0][m][n][e] * rs, b = acc[ai][1][m][n][e] * rs;
                        const float sg = __builtin_amdgcn_rcpf(1.0f + __builtin_amdgcn_exp2f(-1.4426950408889634f * a)); h[4 * n + e] = a * sg * b * H_SCALE; }
                u32x2 w; w.x = pk4f8(h[0], h[1], h[2], h[3]); w.y = pk4f8(h[4], h[5], h[6], h[7]);
                *(u32x2*)(H + (size_t)(u.pm * BM + rl) * EH + col0) = w;
            } }
    }
};
struct EpiY {
    static constexpr bool PERM = true;
    bf16* Y; const float* rowgate; const LAS int* tab;
    __device__ __forceinline__ const float* rsc_src(const Unit& u) const { return rowgate + (size_t)u.e * CAP + u.mt * 256; }
    __device__ __forceinline__ void operator()(const f32x4 (&acc)[2][2][4][2], const Unit& u, int wr, int wc, int fr, int fq, const LAS float* rsc) const {
        const int pnl = u.pn & 3, col0 = 256 * pnl + 32 * wc + 8 * fq;
#pragma unroll
        for (int ai = 0; ai < 2; ++ai) { if (ai == 1 && u.light) break;
#pragma unroll
            for (int m = 0; m < 4; ++m) {
                const int rl = ai * HALF + wr * 64 + m * 16 + fr, idx = u.mt * 256 + rl; const bool valid = idx < u.cnt;
                const float gt = valid ? rsc[rl] * (1.0f / (W2_SCALE * H_SCALE)) : 0.f;
                if (!valid) continue;
                bf16* rowp = Y + (size_t)(tab[259 + u.e] + idx) * DM + col0;
#pragma unroll
                for (int bj = 0; bj < 2; ++bj) { const f32x4 v0 = acc[ai][bj][m][0] * gt, v1 = acc[ai][bj][m][1] * gt;
                    u32x4 w; w.x = pk2(v0[0], v0[1]); w.y = pk2(v0[2], v0[3]); w.z = pk2(v1[0], v1[1]); w.w = pk2(v1[2], v1[3]); *(u32x4*)(rowp + bj * HALF) = w; }
            } }
    }
};
}

#define XB_TMO      128
#define XB_XCNT(j)  (256  + 64 * (j))
#define XB_XSUB(j)  (1280 + 64 * (j))
#define XB_XGEN(j)  (2304 + 64 * (j))
#define XB_TOP      3328
#define XB_TOPGEN   3392
#define XCD_BAR_WORDS 3456
#define XB_SPIN_CAP (1u << 18)
__device__ __forceinline__ unsigned xb_ld(unsigned* p)              { return __hip_atomic_load(p, __ATOMIC_RELAXED, __HIP_MEMORY_SCOPE_AGENT); }
__device__ __forceinline__ unsigned xb_add(unsigned* p, unsigned v) { return __hip_atomic_fetch_add(p, v, __ATOMIC_RELAXED, __HIP_MEMORY_SCOPE_AGENT); }
__device__ __forceinline__ unsigned xb_xcc_id() { return (unsigned)__builtin_amdgcn_s_getreg((3 << 11) | 20) & 0xFu; }
#define XB_SPIN(cond, bar) do { unsigned _sp = 0; while (cond) { __builtin_amdgcn_s_sleep(1); \
    if ((++_sp & 255u) == 0u) { if (xb_ld(&(bar)[XB_TMO])) break; if (_sp > XB_SPIN_CAP) { atomicAdd(&(bar)[XB_TMO], 1u); break; } } } } while (0)
struct XcdBarrier { unsigned* bar; unsigned x; volatile LAS unsigned* st; };
__device__ __forceinline__ XcdBarrier xcd_barrier_post(unsigned* bar, volatile LAS unsigned* st) {
    XcdBarrier b; b.bar = bar; b.x = xb_xcc_id(); b.st = st;
    if (threadIdx.x == 0) (void)xb_add(&bar[XB_XCNT(b.x)], 1u);
    return b;
}
__device__ __forceinline__ void xcd_barrier_complete(unsigned* bar, unsigned x, unsigned& nloc, unsigned& nx) {
    const unsigned G = gridDim.x * gridDim.y * gridDim.z;
    unsigned sum, cnt, mine, sp = 0u;
    for (;;) {
        sum = 0u; cnt = 0u; mine = 0u;
#pragma unroll
        for (unsigned j = 0; j < 16; ++j) { const unsigned c = xb_ld(&bar[XB_XCNT(j)]); sum += c; cnt += (c > 0u) ? 1u : 0u; mine = (j == x) ? c : mine; }
        if (sum == G) break;
        __builtin_amdgcn_s_sleep(1);
        if ((++sp & 255u) == 0u) { if (xb_ld(&bar[XB_TMO])) break; if (sp > XB_SPIN_CAP) { atomicAdd(&bar[XB_TMO], 1u); break; } }
    }
    nloc = mine > 0u ? mine : 1u; nx = cnt > 0u ? cnt : 1u;
}
__device__ __forceinline__ void xcd_barrier(const XcdBarrier& b) {
    asm volatile("s_waitcnt vmcnt(0)" ::: "memory");
    __syncthreads();
    if (threadIdx.x == 0) {
        unsigned* bar = b.bar;
        __builtin_amdgcn_s_waitcnt(0);
        unsigned nloc = b.st[0], nx = b.st[1];
        if (nloc == 0u) { xcd_barrier_complete(bar, b.x, nloc, nx); b.st[0] = nloc; b.st[1] = nx; }
        const unsigned old = xb_add(&bar[XB_XSUB(b.x)], 1u);
        const unsigned gen = old / nloc;
        if (old + 1u == (gen + 1u) * nloc) {
            __builtin_amdgcn_fence(__ATOMIC_RELEASE, "agent");
            asm volatile("s_waitcnt vmcnt(0)" ::: "memory");
            const unsigned og = xb_add(&bar[XB_TOP], 1u);
            const unsigned tg = og / nx;
            if (og + 1u == (tg + 1u) * nx) xb_add(&bar[XB_TOPGEN], 1u);
            else XB_SPIN(xb_ld(&bar[XB_TOPGEN]) == tg, bar);
            __builtin_amdgcn_fence(__ATOMIC_ACQUIRE, "agent");
            xb_add(&bar[XB_XGEN(b.x)], 1u);
            asm volatile("s_waitcnt vmcnt(0)" ::: "memory");
        } else {
            XB_SPIN(xb_ld(&bar[XB_XGEN(b.x)]) == gen, bar);
            __builtin_amdgcn_fence(__ATOMIC_ACQUIRE, "agent");
            asm volatile("s_waitcnt vmcnt(0)" ::: "memory");
        }
    }
    __syncthreads();
}

struct XbTicket { unsigned last, gen, tg; };
__device__ __forceinline__ XbTicket xcd_barrier_arrive(const XcdBarrier& b) {
    asm volatile("s_waitcnt vmcnt(0)" ::: "memory");
    __syncthreads();
    XbTicket t; t.last = 0u; t.gen = 0u; t.tg = 0u;
    if (threadIdx.x == 0) {
        unsigned* bar = b.bar;
        __builtin_amdgcn_s_waitcnt(0);
        unsigned nloc = b.st[0], nx = b.st[1];
        if (nloc == 0u) { xcd_barrier_complete(bar, b.x, nloc, nx); b.st[0] = nloc; b.st[1] = nx; }
        const unsigned old = xb_add(&bar[XB_XSUB(b.x)], 1u);
        t.gen = old / nloc;
        if (old + 1u == (t.gen + 1u) * nloc) {
            t.last = 1u;
            __builtin_amdgcn_fence(__ATOMIC_RELEASE, "agent");
            asm volatile("s_waitcnt vmcnt(0)" ::: "memory");
            const unsigned og = xb_add(&bar[XB_TOP], 1u);
            t.tg = og / nx;
            if (og + 1u == (t.tg + 1u) * nx) { xb_add(&bar[XB_TOPGEN], 1u); t.last = 2u; }
        }
    }
    return t;
}
__device__ __forceinline__ void xcd_barrier_wait(const XcdBarrier& b, const XbTicket& t) {
    asm volatile("s_waitcnt vmcnt(0)" ::: "memory");
    if (threadIdx.x == 0) {
        unsigned* bar = b.bar;
        if (t.last != 0u) {
            if (t.last == 1u) XB_SPIN(xb_ld(&bar[XB_TOPGEN]) == t.tg, bar);
            __builtin_amdgcn_fence(__ATOMIC_ACQUIRE, "agent");
            xb_add(&bar[XB_XGEN(b.x)], 1u);
            asm volatile("s_waitcnt vmcnt(0)" ::: "memory");
        } else {
            XB_SPIN(xb_ld(&bar[XB_XGEN(b.x)]) == t.gen, bar);
            __builtin_amdgcn_fence(__ATOMIC_ACQUIRE, "agent");
            asm volatile("s_waitcnt vmcnt(0)" ::: "memory");
        }
    }
    __syncthreads();
}

struct Args { const float* in[21]; float* out; unsigned char* ws; unsigned char* wsh; int ph_lo, ph_hi; };
struct Frame {
    LAS unsigned char* lds; int tid, lane, wave, vcu, G;
    const float* in[21]; float* out; unsigned char* ws; unsigned char* wsh;
};

__device__ __forceinline__ void p0_item(const float* W, int N, const float* gain, int k0, int n0, bf16* WT, int Kd, size_t drow0, LAS float* scr, int lane) {
#pragma unroll 8
    for (int i = 0; i < 32; ++i) { const int kk = 2 * i + (lane >> 5); float v = __builtin_nontemporal_load(W + (size_t)(k0 + kk) * N + n0 + (lane & 31)); if (gain) v *= gain[k0 + kk]; scr[kk * 33 + (lane & 31)] = v; }
    LDS_WAIT(); asm volatile("" ::: "memory");
    const int c = lane & 7;
#pragma unroll
    for (int j = 0; j < 4; ++j) { const int n = (lane >> 3) + 8 * j; const LAS float* s = scr + (8 * c) * 33 + n;
        u32x4 o; o.x = pk2(s[0 * 33], s[1 * 33]); o.y = pk2(s[2 * 33], s[3 * 33]); o.z = pk2(s[4 * 33], s[5 * 33]); o.w = pk2(s[6 * 33], s[7 * 33]);
        *(GAS u32x4*)(WT + (drow0 + n) * (size_t)Kd + k0 + 8 * c) = o; }
    LDS_WAIT(); asm volatile("" ::: "memory");
}
__device__ __forceinline__ void p0_poolfold_item(const float* Wout, const float* proj, const float* scale, int item, bf16* WT, int lane) {
    const int g = item >> 7, cb = (item >> 4) & 7, nb = item & 15, n = nb * 64 + lane, c0 = cb * 8;
    float acc[8];
#pragma unroll
    for (int j = 0; j < 8; ++j) acc[j] = 0.f;
    const float* pr = proj + (size_t)(g * 64 + c0) * 64;
#pragma unroll 8
    for (int e = 0; e < 64; ++e) { const float wo = Wout[(size_t)(512 + 64 * g + e) * DM + n] * scale[64 * g + e];
#pragma unroll
        for (int j = 0; j < 8; ++j) acc[j] += pr[j * 64 + e] * wo; }
    u32x4 o; o.x = pk2(acc[0], acc[1]); o.y = pk2(acc[2], acc[3]); o.z = pk2(acc[4], acc[5]); o.w = pk2(acc[6], acc[7]);
    *(GAS u32x4*)(WT + (size_t)n * DM + 512 + 64 * g + c0) = o;
}
__device__ __forceinline__ void p0_xrow(const float* xrow, bf16* orow, float* rs, int lane) {
    const GAS f32x4* xr = (const GAS f32x4*)xrow + lane;
    f32x4 v[4]; float s = 0.f;
#pragma unroll
    for (int j = 0; j < 4; ++j) { v[j] = xr[64 * j]; s += (v[j].x * v[j].x + v[j].y * v[j].y) + (v[j].z * v[j].z + v[j].w * v[j].w); }
    s = wave_sum(s);
    if (lane == 0) *rs = 1.0f / sqrtf(s * (1.f / DM) + EPS);
    GAS unsigned long long* o8 = (GAS unsigned long long*)orow + lane;
#pragma unroll
    for (int j = 0; j < 4; ++j) o8[64 * j] = (unsigned long long)pk2(v[j].x, v[j].y) | ((unsigned long long)pk2(v[j].z, v[j].w) << 32);
}
__device__ __forceinline__ void p0_memkv(Frame& F, int task, LAS float* myscr, LAS float* grpscr  ) {
    const float* mem = F.in[1]; const float* mnorm = F.in[8]; const float* wkv = F.in[9]; const float* mkn = F.in[11];
    bf16* kvm = (bf16*)(F.ws + WS_KVM);
    const int lane = F.lane, i = lane & 15, kk = lane >> 4, kq = F.wave & 3;
    const int rb = task >> 3, cb = task & 7, row = rb * 16 + i;
    f32x4 acc[4];
#pragma unroll
    for (int nb = 0; nb < 4; ++nb) acc[nb] = (f32x4){0.f, 0.f, 0.f, 0.f};
    float ss = 0.f;
    const float* arow = mem + (size_t)row * DM;
    const float* wb = wkv + cb * 64 + i;
#pragma unroll 2
    for (int st = 0; st < 8; ++st) {
        const int k0 = 256 * kq + 32 * st + 8 * kk;
        const f32x4 a0 = *(const f32x4*)(arow + k0), a1 = *(const f32x4*)(arow + k0 + 4), g0 = *(const f32x4*)(mnorm + k0), g1 = *(const f32x4*)(mnorm + k0 + 4);
        float bv[4][8];
#pragma unroll
        for (int nb = 0; nb < 4; ++nb)
#pragma unroll
            for (int j = 0; j < 8; ++j) bv[nb][j] = wb[(size_t)(k0 + j) * 512 + nb * 16];
        ss += ((a0[0] * a0[0] + a0[1] * a0[1]) + (a0[2] * a0[2] + a0[3] * a0[3])) + ((a1[0] * a1[0] + a1[1] * a1[1]) + (a1[2] * a1[2] + a1[3] * a1[3]));
        const f32x4 p0 = a0 * g0, p1 = a1 * g1;
        u32x4 aw; aw.x = pk2(p0[0], p0[1]); aw.y = pk2(p0[2], p0[3]); aw.z = pk2(p1[0], p1[1]); aw.w = pk2(p1[2], p1[3]);
        const bf16x8 a8 = __builtin_bit_cast(bf16x8, aw);
#pragma unroll
        for (int nb = 0; nb < 4; ++nb) { u32x4 bw; bw.x = pk2(bv[nb][0], bv[nb][1]); bw.y = pk2(bv[nb][2], bv[nb][3]); bw.z = pk2(bv[nb][4], bv[nb][5]); bw.w = pk2(bv[nb][6], bv[nb][7]);
            acc[nb] = __builtin_amdgcn_mfma_f32_16x16x32_bf16(a8, __builtin_bit_cast(bf16x8, bw), acc[nb], 0, 0, 0); }
    }
#pragma unroll
    for (int nb = 0; nb < 4; ++nb)
#pragma unroll
        for (int r = 0; r < 4; ++r) myscr[(nb * 4 + r) * 64 + lane] = acc[nb][r];
    myscr[1024 + lane] = ss;
    LDS_WAIT(); __syncthreads();
    if (kq == 0) {
        float ssum = 0.f;
#pragma unroll
        for (int w = 0; w < 4; ++w) ssum += grpscr[w * 4096 + 1024 + lane];
        ssum += __shfl_xor(ssum, 16); ssum += __shfl_xor(ssum, 32);
        const float rsm = 1.0f / sqrtf(ssum * (1.f / DM) + EPS);
        float v[4][4];
#pragma unroll
        for (int nb = 0; nb < 4; ++nb)
#pragma unroll
            for (int r = 0; r < 4; ++r) { float s = 0.f;
#pragma unroll
                for (int w = 0; w < 4; ++w) s += grpscr[w * 4096 + (nb * 4 + r) * 64 + lane];
                v[nb][r] = s; }
#pragma unroll
        for (int r = 0; r < 4; ++r) { const int rowD = 4 * kk + r; const float rr = __shfl(rsm, rowD);
#pragma unroll
            for (int nb = 0; nb < 4; ++nb) v[nb][r] *= rr; }
        if (cb < 4) {
#pragma unroll
            for (int r = 0; r < 4; ++r) { float s2 = 0.f;
#pragma unroll
                for (int nb = 0; nb < 4; ++nb) s2 += v[nb][r] * v[nb][r];
                s2 += __shfl_xor(s2, 1); s2 += __shfl_xor(s2, 2); s2 += __shfl_xor(s2, 4); s2 += __shfl_xor(s2, 8);
                const float rn = 1.0f / sqrtf(s2 * (1.f / 64.f) + EPS);
#pragma unroll
                for (int nb = 0; nb < 4; ++nb) v[nb][r] *= rn * mkn[nb * 16 + i]; }
        }
#pragma unroll
        for (int r = 0; r < 4; ++r)
#pragma unroll
            for (int nb = 0; nb < 4; ++nb) kvm[(size_t)(rb * 16 + 4 * kk + r) * 512 + cb * 64 + nb * 16 + i] = (bf16)f2bf(v[nb][r]);
    }
    __syncthreads();
}

__device__ __forceinline__ void p0_prologue(Frame& F) {
    LAS float* scr = (LAS float*)(F.lds + F.wave * 16384);
    const int gw = F.vcu * 8 + F.wave, NGW = F.G * 8;
    for (int t2 = F.vcu; t2 < 256; t2 += F.G) p0_memkv(F, t2 * 2 + (F.wave >> 2), scr, (LAS float*)(F.lds + (F.wave & 4) * 16384));
    const float* attn_norm = F.in[2]; const float* w_in = F.in[3]; const float* w_out = F.in[12];
    bf16* WinT = (bf16*)(F.ws + WS_WIN); bf16* WoutT = (bf16*)(F.ws + WS_WOUT);
    constexpr int I_IN = 16 * 64, I_OUT = 12 * 32, I_FOLD = 512;
    constexpr int NITEMS = I_IN + I_OUT + I_FOLD;
    for (int it = gw; it < NITEMS; it += NGW) {
        int r = it;
        if (r < I_IN) { const int kb = r >> 6, nb = r & 63, n0 = nb * 32;
            const int pn = n0 >> 8, wc = (n0 >> 6) & 3, bj = (n0 >> 5) & 1; const size_t drow = (size_t)(256 * pn + 128 * bj + 32 * wc);
            p0_item(w_in, INW, attn_norm, kb * 64, n0, WinT, DM, drow, scr, F.lane); continue; }
        r -= I_IN;
        if (r < I_OUT) { int kb = r >> 5; const int nb = r & 31; if (kb >= 8) kb += 4;
            p0_item(w_out, DM, nullptr, kb * 64, nb * 32, WoutT, DM, (size_t)nb * 32, scr, F.lane); continue; }
        r -= I_OUT;
        p0_poolfold_item(w_out, F.in[6], F.in[7], r, WoutT, F.lane);
    }
    { const float* x = F.in[0]; bf16* XB = (bf16*)(F.wsh + WS_XB); float* RS = (float*)(F.ws + WS_RS);
      for (int m = gw; m < T; m += 2 * NGW) {
          const int m2 = m + NGW; const bool has2 = m2 < T;
          const GAS f32x4* xa = (const GAS f32x4*)(x + (size_t)m * DM) + F.lane; const GAS f32x4* xb2 = (const GAS f32x4*)(x + (size_t)(has2 ? m2 : m) * DM) + F.lane;
          f32x4 va[4], vb[4]; float sa = 0.f, sb = 0.f;
#pragma unroll
          for (int j = 0; j < 4; ++j) { va[j] = __builtin_nontemporal_load(&xa[64 * j]); vb[j] = __builtin_nontemporal_load(&xb2[64 * j]); }
#pragma unroll
          for (int j = 0; j < 4; ++j) { sa += (va[j].x * va[j].x + va[j].y * va[j].y) + (va[j].z * va[j].z + va[j].w * va[j].w); sb += (vb[j].x * vb[j].x + vb[j].y * vb[j].y) + (vb[j].z * vb[j].z + vb[j].w * vb[j].w); }
          sa = wave_sum(sa); sb = wave_sum(sb);
          if (F.lane == 0) { RS[m] = 1.0f / sqrtf(sa * (1.f / DM) + EPS); if (has2) RS[m2] = 1.0f / sqrtf(sb * (1.f / DM) + EPS); }
          GAS unsigned long long* oa = (GAS unsigned long long*)(XB + (size_t)m * DM) + F.lane;
#pragma unroll
          for (int j = 0; j < 4; ++j) oa[64 * j] = (unsigned long long)pk2(va[j].x, va[j].y) | ((unsigned long long)pk2(va[j].z, va[j].w) << 32);
          if (has2) { GAS unsigned long long* ob = (GAS unsigned long long*)(XB + (size_t)m2 * DM) + F.lane;
#pragma unroll
              for (int j = 0; j < 4; ++j) ob[64 * j] = (unsigned long long)pk2(vb[j].x, vb[j].y) | ((unsigned long long)pk2(vb[j].z, vb[j].w) << 32); } } }
    { bf16* RT = (bf16*)(F.ws + WS_RT); const float* wg = F.in[14]; const float* wr = F.in[16];
      const int gt = F.vcu * 512 + F.tid, NGT = F.G * 512;
      for (int idx = gt; idx < 96 * 1024; idx += NGT) { const int j = idx >> 10, k = idx & 1023; float v = 0.f;
          if (j < 8) v = wg[k * 8 + j]; else if (j < 72) v = wr[(size_t)((j - 8) >> 3) * 8192 + k * 8 + ((j - 8) & 7)];
          RT[idx] = (bf16)f2bf(v * F.in[13][k]); }
    }
}

template <int NQ>
__device__ __forceinline__ void cv_item_f8(const float* W, int N, const float* gain, float scale, int k0, int n0, unsigned char* WT, int Kd, size_t drow0, LAS unsigned* scr, int lane) {
#pragma unroll 1
    for (int qt = 0; qt < NQ; ++qt) {
        const int kh = k0 + 64 * qt;
        const float* wp = W + (size_t)kh * N + n0 + lane;
        float v[64];
#pragma unroll
        for (int i = 0; i < 64; ++i) v[i] = __builtin_nontemporal_load(wp + (size_t)i * N);
        if (gain) {
#pragma unroll
            for (int i = 0; i < 64; ++i) v[i] *= gain[kh + i]; }
#pragma unroll
        for (int q = 0; q < 16; ++q) { const int kq = 16 * qt + q; scr[kq * 64 + (lane ^ (2 * (kq >> 2)))] = pk4f8(v[4 * q] * scale, v[4 * q + 1] * scale, v[4 * q + 2] * scale, v[4 * q + 3] * scale); }
    }
    LDS_WAIT(); asm volatile("" ::: "memory");
    constexpr int NC = 4 * NQ;
    const int c = lane % NC;
#pragma unroll
    for (int j = 0; j < NC; ++j) { const int n = lane / NC + (64 / NC) * j; const LAS unsigned* sp = scr + (4 * c) * 64 + (n ^ (2 * c));
        u32x4 o; o.x = sp[0]; o.y = sp[64]; o.z = sp[128]; o.w = sp[192];
        *(GAS u32x4*)(WT + (drow0 + n) * (size_t)Kd + k0 + 16 * c) = o; }
    LDS_WAIT(); asm volatile("" ::: "memory");
}
template <int PART>
__device__ __forceinline__ void expert_convert(Frame& F) {
    LAS unsigned* scr = (LAS unsigned*)(F.lds + F.wave * 16384);
    const int gw = F.vcu * 8 + F.wave, NGW = F.G * 8;
    unsigned char* W13Q = F.wsh + WS_W13; unsigned char* W2Q = F.wsh + WS_W2;
    if constexpr (PART == 0) {
        constexpr int I_E1 = 4 * 8;
        for (int r = gw; r < NEXP * 2 * I_E1; r += NGW) {
            const int e = r / (2 * I_E1); int q = r % (2 * I_E1);
            const int s = q >= I_E1; q -= s * I_E1; const int kb = q >> 3, nb = q & 7, f0 = nb * 64;
            const float* W = (s ? F.in[19] : F.in[18]) + (size_t)e * DM * EH;
            const size_t drow = (size_t)e * 1024 + 256 * (f0 >> 7) + 128 * s + (f0 & 127);
            cv_item_f8<4>(W, EH, F.in[13], W13_SCALE, kb * 256, f0, W13Q, DM, drow, scr, F.lane); }
    } else {
        constexpr int I_E2 = 4 * 16, HALF_ITEMS = NEXP * I_E2 / 2;
        for (int r0 = gw; r0 < HALF_ITEMS; r0 += NGW) {
            const int r = r0 + (PART == 2 ? HALF_ITEMS : 0);
            const int e = r / I_E2, q = r % I_E2, kb = q >> 4, nb = q & 15;
            const float* W = F.in[20] + (size_t)e * EH * DM;
            cv_item_f8<2>(W, DM, nullptr, W2_SCALE, kb * 128, nb * 64, W2Q, EH, (size_t)e * 1024 + nb * 64, scr, F.lane); }
    }
}

struct ATask { const bf16* qp; const bf16* kp; const bf16* vp; bf16* op; float* lp; long qstride, kvstride, ostride; int kfirst, jmin, jmax, lstride; };
__device__ __forceinline__ ATask p2_make_task(const Frame& F, int t, int b, int ci, int h) {
    const bf16* Z = (const bf16*)(F.wsh + WS_Z); const bf16* KVM = (const bf16*)(F.ws + WS_KVM); bf16* MIX = (bf16*)(F.wsh + WS_MIX);
    bf16* PO = (bf16*)(F.wsh + WS_PO); float* LP = (float*)(F.ws + WS_LP);
    ATask a; const long rowbase = (long)b * SEQ; const int s0 = ci * 512;
    if (t == 0) { const int mh = h & 3, sb = 8 * (h >> 2) + F.wave; const long tok0 = rowbase + s0 + 32 * sb;
        a.qp = Z + ((size_t)(28 + mh) * T + tok0) * 64; a.qstride = 64; a.kp = KVM + (size_t)b * NMEM * 512 + 64 * mh; a.vp = a.kp + 256; a.kvstride = 512; a.kfirst = 0; a.jmin = 0; a.jmax = 7;
        a.op = MIX + tok0 * DM + 768 + 64 * mh; a.ostride = DM; a.lp = nullptr; a.lstride = 0; }
    else { const int pat = (t - 1) >> 1, half = (t - 1) & 1, dil = pat == 0 ? 1 : (pat == 1 ? 4 : 16), tk = F.wave + 8 * half;
        int res, q0sub;
        if (pat == 0) { res = 0; q0sub = s0 + 32 * tk; } else if (pat == 1) { res = tk >> 2; q0sub = s0 / 4 + 32 * (tk & 3); } else { res = tk; q0sub = s0 / 16; }
        const long qtok = rowbase + (long)dil * q0sub + res;
        a.qp = Z + ((size_t)h * T + qtok) * 64; a.qstride = (long)dil * 64; a.kp = Z + ((size_t)(8 + h) * T + rowbase + res) * 64; a.vp = a.kp + (size_t)8 * T * 64; a.kvstride = (long)dil * 64;
        a.kfirst = q0sub - 128; a.jmin = q0sub >= 128 ? 0 : (128 - q0sub) / 32; a.jmax = 4;
        a.op = PO + ((size_t)pat * T + qtok) * 512 + 64 * h; a.ostride = (long)dil * 512; a.lp = LP + ((size_t)pat * T + qtok) * 8 + h; a.lstride = dil * 8; }
    return a;
}
__device__ __forceinline__ void kload4(bf16x8 (&k)[4], const bf16* p) {
    asm volatile("global_load_dwordx4 %0, %4, off\n\tglobal_load_dwordx4 %1, %4, off offset:32\n\tglobal_load_dwordx4 %2, %4, off offset:64\n\tglobal_load_dwordx4 %3, %4, off offset:96"
                 : "=&v"(k[0]), "=&v"(k[1]), "=&v"(k[2]), "=&v"(k[3]) : "v"(p) : "memory");
}
__device__ __forceinline__ void glds16(const void* gsrc, unsigned lds_dst) { unsigned keep;
    asm volatile("s_mov_b32 %0, m0\n\ts_mov_b32 m0, %2\n\ts_nop 0\n\tglobal_load_lds_dwordx4 %1, off\n\ts_mov_b32 m0, %0" : "=&s"(keep) : "v"(gsrc), "s"(lds_dst) : "memory"); }
__device__ __forceinline__ void p2_attention(Frame& F) {
    const bf16* Z = (const bf16*)(F.wsh + WS_Z); bf16* MIX = (bf16*)(F.wsh + WS_MIX);
    const bf16* PO = (const bf16*)(F.wsh + WS_PO); const float* LP = (const float*)(F.ws + WS_LP);
    LAS unsigned char* wl = F.lds + F.wave * 16384; LAS float* wsf = (LAS float*)(F.lds + WSCR_OFF + F.wave * 256);
    const unsigned wl0 = (unsigned)(uintptr_t)wl;
    const int lane = F.lane, r32 = lane & 31, hi = lane >> 5;
    const int vlane = ((lane >> 4) & 1) * 32 + (lane & 3) * 8 + (4 * hi + ((lane & 15) >> 2)) * 64;
    for (int cid = F.vcu; cid < 256; cid += F.G) {
        const int b = cid >> 6, h = 4 * ((cid >> 5) & 1) + (cid & 3), ci = (cid >> 2) & 7;
        const int s0 = ci * 512; const long rowbase = (long)b * SEQ;
        { LAS unsigned char* pl = F.lds; const int g = h >> 1;
          { const bf16* up = Z + ((size_t)(24 + (h >> 1)) * T + rowbase + s0 + F.tid) * 64 + 32 * (h & 1); u32x4 v[4];
#pragma unroll
            for (int q = 0; q < 4; ++q) v[q] = *(const u32x4*)(up + 8 * q);
            u32x4 hv[4];
            if (F.tid < 15) {
#pragma unroll
                for (int q = 0; q < 4; ++q) hv[q] = (s0 > 0) ? *(const u32x4*)(up - 15L * 64 + 8 * q) : (u32x4){0u, 0u, 0u, 0u}; }
#pragma unroll
            for (int q = 0; q < 4; ++q) *(LAS u32x4*)(pl + (F.tid + 15) * 80 + 16 * q) = v[q];
            if (F.tid < 15) {
#pragma unroll
                for (int q = 0; q < 4; ++q) *(LAS u32x4*)(pl + F.tid * 80 + 16 * q) = hv[q]; } }
          LDS_WAIT(); __syncthreads();
          const int s = s0 + F.tid, w = 2 << g, cnt = (s + 1 < w) ? s + 1 : w;
          float a[32];
#pragma unroll
          for (int c = 0; c < 32; ++c) a[c] = 0.f;
          u32x4 us[4];
          const LAS unsigned char* pr = pl + (F.tid + 15) * 80;
#pragma unroll
          for (int q = 0; q < 4; ++q) us[q] = *(const LAS u32x4*)(pr + 16 * q);
#pragma unroll 2
          for (int r = 0; r < w; ++r) {
#pragma unroll
              for (int q = 0; q < 4; ++q) { const u32x4 v = *(const LAS u32x4*)(pr - r * 80 + 16 * q);
                  a[8 * q + 0] += bflo(v.x); a[8 * q + 1] += bfhi(v.x); a[8 * q + 2] += bflo(v.y); a[8 * q + 3] += bfhi(v.y);
                  a[8 * q + 4] += bflo(v.z); a[8 * q + 5] += bfhi(v.z); a[8 * q + 6] += bflo(v.w); a[8 * q + 7] += bfhi(v.w); } }
          const float inv = 1.0f / (float)cnt;
          bf16* op = MIX + (rowbase + s) * DM + 512 + 32 * h;
#pragma unroll
          for (int q = 0; q < 4; ++q) { u32x4 w4;
              w4.x = pk2(a[8 * q + 0] * inv - bflo(us[q].x), a[8 * q + 1] * inv - bfhi(us[q].x)); w4.y = pk2(a[8 * q + 2] * inv - bflo(us[q].y), a[8 * q + 3] * inv - bfhi(us[q].y));
              w4.z = pk2(a[8 * q + 4] * inv - bflo(us[q].z), a[8 * q + 5] * inv - bfhi(us[q].z)); w4.w = pk2(a[8 * q + 6] * inv - bflo(us[q].w), a[8 * q + 7] * inv - bfhi(us[q].w));
              *(u32x4*)(op + 8 * q) = w4; }
          LDS_WAIT(); __syncthreads(); }
        VM_WAIT();
        ATask ia = p2_make_task(F, 0, b, ci, h), ca = ia; int it = 0, ij = ia.jmin, ct = 0, cj = ia.jmin;
        bf16x8 kA[4], kB[4], kC[4], qr[4];
        const LAS unsigned char* qb = wl + 12288;
#define P2_QDMA(A) do { const bf16* qs_ = (A).qp + (long)(lane >> 3) * (A).qstride + (lane & 7) * 8; \
            _Pragma("unroll") for (int i_ = 0; i_ < 4; ++i_) glds16(qs_ + (long)(8 * i_) * (A).qstride, (unsigned)__builtin_amdgcn_readfirstlane(wl0 + 12288 + i_ * 1024)); } while (0)
#define P2_QREAD() do { _Pragma("unroll") for (int d0 = 0; d0 < 4; ++d0) qr[d0] = *(const LAS bf16x8*)(qb + r32 * 128 + d0 * 32 + hi * 16); LDS_WAIT(); asm volatile("" ::: "memory"); } while (0)
        P2_QDMA(ca);
        asm volatile("s_waitcnt vmcnt(0)" ::: "memory");
        P2_QREAD();
        { const ATask na = p2_make_task(F, 1, b, ci, h); P2_QDMA(na); }
#define P2_ISSUE(KS, slot) do { const long tb_ = (long)(ia.kfirst + 32 * ij) * ia.kvstride; \
            kload4(KS, ia.kp + tb_ + (long)r32 * ia.kvstride + 8 * hi); \
            const bf16* vt_ = ia.vp + tb_ + (long)(lane >> 2) * ia.kvstride + (lane & 3) * 8; \
            _Pragma("unroll") for (int i_ = 0; i_ < 4; ++i_) glds16(vt_ + (long)(i_ & 1) * 16 * ia.kvstride + (i_ >> 1) * 32, (unsigned)__builtin_amdgcn_readfirstlane(wl0 + (slot) * 4096 + i_ * 1024)); \
            if (ij < ia.jmax) ++ij; else if (it < 6) { ++it; ia = p2_make_task(F, it, b, ci, h); ij = ia.jmin; } } while (0)
        P2_ISSUE(kA, 0); P2_ISSUE(kB, 1);
        f32x16 o[2]; float lacc = 0.f;
#pragma unroll
        for (int r = 0; r < 16; ++r) { o[0][r] = 0.f; o[1][r] = 0.f; }
        bool done = false;
#define P2_STEP(KC, KI, slotc, sloti) do { \
            P2_ISSUE(KI, sloti); \
            asm volatile("s_waitcnt vmcnt(16) ; KSET %0 %1 %2 %3" : "+v"(KC[0]), "+v"(KC[1]), "+v"(KC[2]), "+v"(KC[3]) :: "memory"); \
            __builtin_amdgcn_sched_barrier(0); \
              \
            const LAS unsigned char* vb = wl + (slotc) * 4096; \
            bf16x8 vf[2][2]; \
            _Pragma("unroll") for (int d0 = 0; d0 < 2; ++d0) { \
                _Pragma("unroll") for (int ks = 0; ks < 2; ++ks) { \
                    const LAS unsigned char* vp_ = vb + (d0 * 2 + ks) * 1024 + vlane; \
                    const s16x4 lo = __builtin_bit_cast(s16x4, __builtin_amdgcn_ds_read_tr16_b64_v4i16((LAS s16x4*)vp_)); \
                    const s16x4 hh = __builtin_bit_cast(s16x4, __builtin_amdgcn_ds_read_tr16_b64_v4i16((LAS s16x4*)(vp_ + 512))); \
                    vf[d0][ks] = (bf16x8){lo[0], lo[1], lo[2], lo[3], hh[0], hh[1], hh[2], hh[3]}; } } \
            __builtin_amdgcn_sched_barrier(0); \
            f32x16 p; \
            _Pragma("unroll") for (int r = 0; r < 16; ++r) p[r] = 0.f; \
            _Pragma("unroll") for (int d0 = 0; d0 < 4; ++d0) p = __builtin_amdgcn_mfma_f32_32x32x16_bf16(KC[d0], qr[d0], p, 0, 0, 0); \
            const int mm = (ct > 0) ? (cj == 0 ? 1 : (cj == 4 ? 2 : 0)) : 0; \
            _Pragma("unroll") for (int r = 0; r < 16; ++r) p[r] = __builtin_amdgcn_exp2f(p[r]); \
            if (mm != 0) { const int klo = (mm == 1) ? r32 : -1, khi = (mm == 2) ? r32 : 64; \
                _Pragma("unroll") for (int r = 0; r < 16; ++r) { const int kj = crow(r, hi); p[r] = (kj >= klo && kj <= khi) ? p[r] : 0.f; } } \
            lacc += (((p[0] + p[1]) + (p[2] + p[3])) + ((p[4] + p[5]) + (p[6] + p[7]))) + (((p[8] + p[9]) + (p[10] + p[11])) + ((p[12] + p[13]) + (p[14] + p[15]))); \
            u32x4 pw0, pw1; \
            pw0.x = pk2(p[0], p[1]); pw0.y = pk2(p[2], p[3]); pw0.z = pk2(p[4], p[5]); pw0.w = pk2(p[6], p[7]); \
            pw1.x = pk2(p[8], p[9]); pw1.y = pk2(p[10], p[11]); pw1.z = pk2(p[12], p[13]); pw1.w = pk2(p[14], p[15]); \
            const bf16x8 pa0 = __builtin_bit_cast(bf16x8, pw0), pa1 = __builtin_bit_cast(bf16x8, pw1); \
            _Pragma("unroll") for (int d0 = 0; d0 < 2; ++d0) { \
                _Pragma("unroll") for (int ks = 0; ks < 2; ++ks) o[d0] = __builtin_amdgcn_mfma_f32_32x32x16_bf16(ks ? pa1 : pa0, vf[d0][ks], o[d0], 0, 0, 0); } \
            asm volatile("" ::: "memory"); \
            if (cj == ca.jmax) { \
                LAS bf16* stg = (LAS bf16*)(wl + (slotc) * 4096);            \
                const float l = lacc + __shfl_xor(lacc, 32); \
                if (hi == 0) wsf[r32] = 1.0f / l; \
                LDS_WAIT(); asm volatile("" ::: "memory"); \
                _Pragma("unroll") for (int r = 0; r < 16; ++r) { const int qq = crow(r, hi); const float iv = wsf[qq]; \
                    _Pragma("unroll") for (int d0 = 0; d0 < 2; ++d0) stg[qq * 64 + 32 * d0 + r32] = (bf16)f2bf(o[d0][r] * iv); } \
                LDS_WAIT(); asm volatile("" ::: "memory"); \
                u32x4 ov[4]; \
                _Pragma("unroll") for (int i_ = 0; i_ < 4; ++i_) ov[i_] = *(const LAS u32x4*)(stg + (i_ * 8 + (lane >> 3)) * 64 + (lane & 7) * 8); \
                LDS_WAIT(); asm volatile("" ::: "memory"); \
                if (ct < 6) { asm volatile("s_waitcnt vmcnt(8)" ::: "memory");     \
                    P2_QREAD(); \
                    if (ct < 5) { const ATask na = p2_make_task(F, ct + 2, b, ci, h); P2_QDMA(na); } } \
                if (hi == 0 && ca.lp) ca.lp[(long)r32 * ca.lstride] = l; \
                _Pragma("unroll") for (int i_ = 0; i_ < 4; ++i_) *(u32x4*)(ca.op + (long)(i_ * 8 + (lane >> 3)) * ca.ostride + (lane & 7) * 8) = ov[i_]; \
                if (ct == 6) done = true; \
                else { ++ct; ca = p2_make_task(F, ct, b, ci, h); cj = ca.jmin; \
                    _Pragma("unroll") for (int r = 0; r < 16; ++r) { o[0][r] = 0.f; o[1][r] = 0.f; } lacc = 0.f; } \
            } else ++cj; } while (0)
        for (;;) {
            P2_STEP(kA, kC, 0, 2); if (done) break;
            P2_STEP(kB, kA, 1, 0); if (done) break;
            P2_STEP(kC, kB, 2, 1); if (done) break;
        }
#undef P2_STEP
#undef P2_ISSUE
#undef P2_QDMA
#undef P2_QREAD
        asm volatile("s_waitcnt vmcnt(0) ; KSETS %0 %1 %2" : "+v"(kA[0]), "+v"(kB[0]), "+v"(kC[0]) :: "memory");
        asm volatile("" : "+v"(kA[1]), "+v"(kA[2]), "+v"(kA[3]), "+v"(kB[1]), "+v"(kB[2]), "+v"(kB[3]), "+v"(kC[1]), "+v"(kC[2]), "+v"(kC[3]));
        __syncthreads();
        { const long row = rowbase + s0 + F.tid;
          const float l0 = LP[((size_t)0 * T + row) * 8 + h], l1 = LP[((size_t)1 * T + row) * 8 + h], l2 = LP[((size_t)2 * T + row) * 8 + h];
          const float il = 1.0f / (l0 + l1 + l2), w0 = l0 * il, w1 = l1 * il, w2 = l2 * il;
          const bf16* p0 = PO + ((size_t)0 * T + row) * 512 + 64 * h; const bf16* p1 = PO + ((size_t)1 * T + row) * 512 + 64 * h; const bf16* p2 = PO + ((size_t)2 * T + row) * 512 + 64 * h;
          bf16* op = MIX + row * DM + 64 * h;
#pragma unroll
          for (int c = 0; c < 8; ++c) { const u32x4 a = *(const u32x4*)(p0 + 8 * c), bb = *(const u32x4*)(p1 + 8 * c), cc = *(const u32x4*)(p2 + 8 * c); u32x4 w;
              w.x = pk2(w0 * bflo(a.x) + w1 * bflo(bb.x) + w2 * bflo(cc.x), w0 * bfhi(a.x) + w1 * bfhi(bb.x) + w2 * bfhi(cc.x));
              w.y = pk2(w0 * bflo(a.y) + w1 * bflo(bb.y) + w2 * bflo(cc.y), w0 * bfhi(a.y) + w1 * bfhi(bb.y) + w2 * bfhi(cc.y));
              w.z = pk2(w0 * bflo(a.z) + w1 * bflo(bb.z) + w2 * bflo(cc.z), w0 * bfhi(a.z) + w1 * bfhi(bb.z) + w2 * bfhi(cc.z));
              w.w = pk2(w0 * bflo(a.w) + w1 * bflo(bb.w) + w2 * bflo(cc.w), w0 * bfhi(a.w) + w1 * bfhi(bb.w) + w2 * bfhi(cc.w));
              *(u32x4*)(op + 8 * c) = w; } }
        VM_WAIT(); __syncthreads();
    }
}

__device__ __forceinline__ void p4_router(Frame& F) {
    const bf16* XG = (const bf16*)(F.wsh + WS_XG); const bf16* RT = (const bf16*)(F.ws + WS_RT); const float* SSQ = (const float*)(F.ws + WS_SSQ);
    unsigned* TOKPOS = (unsigned*)(F.ws + WS_TOKPOS); unsigned* ROWTOK = (unsigned*)(F.ws + WS_ROWTOK); float* ROWGATE = (float*)(F.ws + WS_ROWGATE);
    unsigned* CNT = (unsigned*)(F.ws + WS_CTL) + CW_CNT; float* ROWRSTD = (float*)(F.ws + WS_ROWRSTD);
    const float* bg = F.in[15]; const float* br = F.in[17]; unsigned char* X1Q = F.wsh + WS_X1Q;
    LAS float* PL = (LAS float*)F.lds;
    LAS unsigned* hist = (LAS unsigned*)(F.lds + 100352); LAS unsigned* hbase = hist + 64;
    const int lane = F.lane, r32 = lane & 31, hi = lane >> 5, tb = F.wave >> 2, kq = F.wave & 3;
    if (F.vcu == 0 && F.tid < 256) ((unsigned*)(X1Q + (size_t)T * DM))[F.tid] = 0u;
    for (int tg = F.vcu; tg < T / 64; tg += F.G) {
        const int tok = tg * 64 + tb * 32 + r32;
        f32x16 acc[3];
#pragma unroll
        for (int nb = 0; nb < 3; ++nb)
#pragma unroll
            for (int r = 0; r < 16; ++r) acc[nb][r] = 0.f;
        const bf16* ap = XG + (size_t)tok * DM + 256 * kq + 8 * hi; const bf16* bp = RT + (size_t)r32 * DM + 256 * kq + 8 * hi;
#pragma unroll 4
        for (int s = 0; s < 16; ++s) { const bf16x8 a = *(const bf16x8*)(ap + 16 * s);
            { const u32x4 aw = __builtin_bit_cast(u32x4, a); u32x2 q8; q8.x = pk4f8(bflo(aw.x), bfhi(aw.x), bflo(aw.y), bfhi(aw.y)); q8.y = pk4f8(bflo(aw.z), bfhi(aw.z), bflo(aw.w), bfhi(aw.w));
              *(u32x2*)(X1Q + (size_t)tok * DM + 256 * kq + 16 * s + 8 * hi) = q8; }
#pragma unroll
            for (int nb = 0; nb < 3; ++nb) { const bf16x8 bb = *(const bf16x8*)(bp + (size_t)nb * 32 * DM + 16 * s); acc[nb] = __builtin_amdgcn_mfma_f32_32x32x16_bf16(bb, a, acc[nb], 0, 0, 0); } }
        LAS float* pw = PL + (size_t)(F.wave * 32 + r32) * 97;
#pragma unroll
        for (int nb = 0; nb < 3; ++nb)
#pragma unroll
            for (int r = 0; r < 16; ++r) pw[32 * nb + crow(r, hi)] = acc[nb][r];
        if (F.tid < 64) hist[F.tid] = 0u;
        LDS_WAIT(); __syncthreads();
        int e1 = 0, e2 = 0; unsigned k1 = 0, k2 = 0; float g1 = 0.f, g2 = 0.f, rstdv = 0.f;
        if (F.tid < 64) {
            const int t2 = F.tid >> 5, rr = F.tid & 31, tk = tg * 64 + F.tid;
            const LAS float* p0 = PL + (size_t)((t2 * 4) * 32 + rr) * 97;
#define LOGIT(n) (p0[(n)] + p0[32 * 97 + (n)] + p0[64 * 97 + (n)] + p0[96 * 97 + (n)])
            float ss = 0.f;
#pragma unroll
            for (int i = 0; i < 4; ++i) { const f32x4 v = *(const f32x4*)(SSQ + (size_t)tk * 16 + 4 * i); ss += (v[0] + v[1]) + (v[2] + v[3]); }
            const float rstd = 1.0f / sqrtf(ss * (1.f / DM) + EPS);
            float lg[8]; int g = 0; float gm = -3.0e38f;
#pragma unroll
            for (int j = 0; j < 8; ++j) { lg[j] = rstd * LOGIT(j) + bg[j]; if (lg[j] > gm) { gm = lg[j]; g = j; } }
            float den = 0.f;
#pragma unroll
            for (int j = 0; j < 8; ++j) den += __expf(lg[j] - gm);
            const float pg = 1.0f / den;
            float le[8]; int i1 = 0; float v1 = -3.0e38f;
#pragma unroll
            for (int j = 0; j < 8; ++j) { le[j] = rstd * LOGIT(8 + 8 * g + j) + br[8 * g + j]; if (le[j] > v1) { v1 = le[j]; i1 = j; } }
            int i2 = 0; float v2 = -3.0e38f;
#pragma unroll
            for (int j = 0; j < 8; ++j) { if (j != i1 && le[j] > v2) { v2 = le[j]; i2 = j; } }
#undef LOGIT
            const float p1 = 1.0f / (1.0f + __expf(v2 - v1)), p2 = 1.0f - p1;
            rstdv = rstd;
            e1 = 8 * g + i1; e2 = 8 * g + i2; g1 = pg * p1; g2 = pg * p2;
            k1 = __hip_atomic_fetch_add(&hist[e1], 1u, __ATOMIC_RELAXED, __HIP_MEMORY_SCOPE_WORKGROUP); k2 = __hip_atomic_fetch_add(&hist[e2], 1u, __ATOMIC_RELAXED, __HIP_MEMORY_SCOPE_WORKGROUP);
        }
        LDS_WAIT(); __syncthreads();
        if (F.tid < 64) { const unsigned n = hist[F.tid]; hbase[F.tid] = n ? atomicAdd(&CNT[F.tid * CNT_STRIDE], n) : 0u; }
        LDS_WAIT(); __syncthreads();
        if (F.tid < 64) { const int tk = tg * 64 + F.tid;
            const unsigned sl1 = (unsigned)e1 * CAP + hbase[e1] + k1, sl2 = (unsigned)e2 * CAP + hbase[e2] + k2;
            ROWTOK[sl1] = (unsigned)tk; ROWGATE[sl1] = g1; ROWRSTD[sl1] = rstdv; ROWTOK[sl2] = (unsigned)tk; ROWGATE[sl2] = g2; ROWRSTD[sl2] = rstdv;
            TOKPOS[2 * tk] = sl1; TOKPOS[2 * tk + 1] = sl2;
        }
        __syncthreads();
    }
}

__device__ __forceinline__ void p7_combine(Frame& F, const LAS int* tab) {
    const unsigned* TOKPOS = (const unsigned*)(F.ws + WS_TOKPOS); const bf16* YB = (const bf16*)(F.wsh + WS_YB);
    const int gw = F.vcu * 8 + F.wave, NGW = F.G * 8;
    for (int m = gw; m < T; m += NGW) {
        const unsigned s1 = TOKPOS[2 * m], s2 = TOKPOS[2 * m + 1];
        const size_t h1 = (size_t)tab[259 + (s1 >> 15)] + (s1 & 32767u), h2 = (size_t)tab[259 + (s2 >> 15)] + (s2 & 32767u);
        const GAS u32x2* x1 = (const GAS u32x2*)((const bf16*)(F.wsh + WS_XG) + (size_t)m * DM) + F.lane; GAS f32x4* od = (GAS f32x4*)(F.out + (size_t)m * DM) + F.lane;
        const GAS u32x2* y1 = (const GAS u32x2*)(YB + h1 * DM) + F.lane; const GAS u32x2* y2 = (const GAS u32x2*)(YB + h2 * DM) + F.lane;
#pragma unroll
        for (int j = 0; j < 4; ++j) { const u32x2 xx = __builtin_nontemporal_load(&x1[64 * j]), a = __builtin_nontemporal_load(&y1[64 * j]), b = __builtin_nontemporal_load(&y2[64 * j]); f32x4 v;
            v[0] = bflo(xx.x) + (bflo(a.x) + bflo(b.x)); v[1] = bfhi(xx.x) + (bfhi(a.x) + bfhi(b.x)); v[2] = bflo(xx.y) + (bflo(a.y) + bflo(b.y)); v[3] = bfhi(xx.y) + (bfhi(a.y) + bfhi(b.y)); __builtin_nontemporal_store(v, &od[64 * j]); }
    }
}

__global__ void __launch_bounds__(512, 2) fwd_kernel(Args args) {
    extern __shared__ __attribute__((aligned(16))) unsigned char lds[];
    Frame F;
    F.lds = (LAS unsigned char*)lds; F.tid = threadIdx.x; F.lane = F.tid & 63; F.wave = __builtin_amdgcn_readfirstlane(F.tid >> 6);
    F.G = gridDim.x; { const int bx = blockIdx.x; F.vcu = (F.G % 8 == 0) ? (bx % 8) * (F.G / 8) + bx / 8 : bx; }
#pragma unroll
    for (int i = 0; i < 21; ++i) F.in[i] = args.in[i];
    F.out = args.out; F.ws = args.ws; F.wsh = args.wsh;
    volatile LAS unsigned* MISC = (volatile LAS unsigned*)(F.lds + MISC_OFF);
    for (int u = F.tid; u < (LDS_BYTES - LDSCTL_OFF) / 4; u += 512) ((LAS unsigned*)(F.lds + LDSCTL_OFF))[u] = 0u;
    __syncthreads();
    unsigned* ctl = (unsigned*)(F.ws + WS_CTL);
    XcdBarrier bar = xcd_barrier_post(ctl + CW_BAR, MISC + 8);
    const int lo = args.ph_lo, hi = args.ph_hi;
#define IN(k) (lo <= (k) && (k) < hi)
#define SEAM(k) do { if (IN(k) && IN((k) + 1)) xcd_barrier(bar); } while (0)
    LAS int* tab = (LAS int*)(F.lds + TAB_OFF);

    if (IN(0)) { p0_prologue(F); }
    SEAM(0);
    if (IN(1)) {
        pg8::Gemm g{(const bf16*)(F.wsh + WS_XB), (const bf16*)(F.ws + WS_WIN), DM}; pg8::StaticOrder S; S.init(T, INW, F.G, (int)blockIdx.x);
        LAS float* gz = (LAS float*)(F.lds + GZ_OFF);
        if (F.tid < 192) gz[F.tid] = F.tid < 64 ? F.in[4][F.tid] * C2 : (F.tid < 128 ? F.in[5][F.tid - 64] : F.in[10][F.tid - 128] * C2);
        LDS_WAIT(); __syncthreads();
        pg8::EpiZ E{(bf16*)(F.wsh + WS_Z), (const float*)(F.ws + WS_RS), gz};
        pg8::gemm_phase<pg8::EpiZ, pg8::StaticOrder, false, false>(F.lds, g, S, E);
    }
    SEAM(1);
    if (IN(2)) { p2_attention(F); }
    { const XbTicket t23 = xcd_barrier_arrive(bar); expert_convert<1>(F); LDS_WAIT(); xcd_barrier_wait(bar, t23); }
    if (IN(3)) {
        pg8::Gemm g{(const bf16*)(F.wsh + WS_MIX), (const bf16*)(F.ws + WS_WOUT), DM}; pg8::StaticOrder S; S.init(T, DM, F.G, (int)blockIdx.x);
        pg8::EpiX1 E{(const bf16*)(F.wsh + WS_XB), (bf16*)(F.wsh + WS_XG), (float*)(F.ws + WS_SSQ)};
        pg8::gemm_phase<pg8::EpiX1, pg8::StaticOrder, false, false>(F.lds, g, S, E);
    }
    const XbTicket t34 = xcd_barrier_arrive(bar);
    expert_convert<0>(F);
    LDS_WAIT();
    xcd_barrier_wait(bar, t34);
    p4_router(F);
    const XbTicket t45 = xcd_barrier_arrive(bar);
    expert_convert<2>(F);
    LDS_WAIT();
    xcd_barrier_wait(bar, t45);
    if (IN(5) || IN(6) || IN(7)) {
        if (F.tid < 64) { const int c = (int)__hip_atomic_load(ctl + CW_CNT + F.tid * CNT_STRIDE, RLX_AGENT); const int ntl = (c + 255) >> 8;
            const int lt = (ntl > 0 && c - (ntl - 1) * 256 <= 128) ? 1 : 0; int i0 = ntl, i1 = ntl - lt, i2 = lt, i3 = c;
#pragma unroll
            for (int o = 1; o < 64; o <<= 1) { const int v0 = __shfl_up(i0, o), v1 = __shfl_up(i1, o), v2 = __shfl_up(i2, o), v3 = __shfl_up(i3, o); if (F.lane >= o) { i0 += v0; i1 += v1; i2 += v2; i3 += v3; } }
            tab[F.tid] = c; tab[64 + F.tid + 1] = i0; tab[129 + F.tid + 1] = i1; tab[194 + F.tid + 1] = i2; tab[259 + F.tid + 1] = i3; if (F.tid == 0) { tab[64] = 0; tab[129] = 0; tab[194] = 0; tab[259] = 0; } }
        LDS_WAIT(); __syncthreads();
    }
    if (IN(5)) {
        pg8::Gemm g{(const bf16*)(F.wsh + WS_X1Q), (const bf16*)(F.wsh + WS_W13), DM / 2};
        pg8::GroupOrder S{tab, (const unsigned*)(F.ws + WS_ROWTOK), F.G, (int)blockIdx.x};
        pg8::EpiH E{F.wsh + WS_HMID, (const float*)(F.ws + WS_ROWRSTD)};
        pg8::gemm_phase<pg8::EpiH, pg8::GroupOrder, true, true>(F.lds, g, S, E);
    }
    SEAM(5);
    if (IN(6)) {
        pg8::Gemm g{(const bf16*)(F.wsh + WS_HMID), (const bf16*)(F.wsh + WS_W2), EH / 2};
        pg8::GroupOrder S{tab, (const unsigned*)(F.ws + WS_ROWTOK), F.G, (int)blockIdx.x};
        pg8::EpiY E{(bf16*)(F.wsh + WS_YB), (const float*)(F.ws + WS_ROWGATE), tab};
        pg8::gemm_phase<pg8::EpiY, pg8::GroupOrder, false, true>(F.lds, g, S, E);
    }
    SEAM(6);
    if (IN(7)) { p7_combine(F, tab); }
#undef IN
#undef SEAM
}

extern "C" void kernel_launch(void* const* d_in, const int* in_sizes, int n_in, void* d_out, int out_size, void* d_ws, size_t ws_size, hipStream_t stream) {
    static int grid = 0;
    if (grid == 0) {
        if (n_in != 21 || out_size != T * DM || ws_size < WS_END) { fprintf(stderr, "kernel_launch: unexpected shapes (n_in %d out %d ws %zu)\n", n_in, out_size, ws_size); grid = -1; return; }
        int dev = 0, cus = 0, per_cu = 0;
        if (hipGetDevice(&dev) != hipSuccess || hipDeviceGetAttribute(&cus, hipDeviceAttributeMultiprocessorCount, dev) != hipSuccess) { grid = -1; return; }
        if (hipFuncSetAttribute((const void*)fwd_kernel, hipFuncAttributeMaxDynamicSharedMemorySize, LDS_BYTES) != hipSuccess) { fprintf(stderr, "kernel_launch: hipFuncSetAttribute failed\n"); grid = -1; return; }
        if (hipOccupancyMaxActiveBlocksPerMultiprocessor(&per_cu, (const void*)fwd_kernel, 512, LDS_BYTES) != hipSuccess || per_cu < 1) { fprintf(stderr, "kernel_launch: occupancy query says %d\n", per_cu); }
        (void)hipGetLastError();
        grid = cus;
    }
    if (grid < 0) return;
    if (hipMemsetAsync((char*)d_ws + WS_CTL, 0, CTL_ZERO_BYTES, stream) != hipSuccess) return;
    Args a{};
    for (int i = 0; i < 21; ++i) a.in[i] = (const float*)d_in[i];
    a.out = (float*)d_out; a.ws = (unsigned char*)d_ws; a.wsh = (unsigned char*)d_ws + (((ws_size >> 20) << 20) - WS_END); a.ph_lo = 0; a.ph_hi = 8;
    hipLaunchKernelGGL(fwd_kernel, dim3(grid), dim3(512), LDS_BYTES, stream, a);
}
```

```cpp
#include <hip/hip_runtime.h>
#include <cstdio>
#include <cstdint>

#define LAS __attribute__((address_space(3)))
#define GAS __attribute__((address_space(1)))
typedef unsigned short bf16;
typedef short bf16x8 __attribute__((ext_vector_type(8)));
typedef short s16x4 __attribute__((ext_vector_type(4)));
typedef float f32x4 __attribute__((ext_vector_type(4)));
typedef float f32x16 __attribute__((ext_vector_type(16)));
typedef float f32x2 __attribute__((ext_vector_type(2)));
typedef __bf16 bf16x2_t __attribute__((ext_vector_type(2)));
typedef unsigned u32x4 __attribute__((ext_vector_type(4)));
typedef unsigned u32x2 __attribute__((ext_vector_type(2)));
typedef GAS unsigned gu32;
typedef int v4i __attribute__((ext_vector_type(4)));
typedef int v8i __attribute__((ext_vector_type(8)));

constexpr int BATCH = 4, SEQ = 4096, DM = 1024, T = BATCH * SEQ;
constexpr int INW = 2048, NMEM = 256;
constexpr int NEXP = 64, EH = 512, CAP = 32768;
constexpr float EPS = 1e-6f;
constexpr float W13_SCALE = 64.f, W2_SCALE = 32.f, H_SCALE = 4.f, F8MAX = 448.f;
constexpr float C2 = 0.125f * 1.4426950408889634f;
constexpr int ZQ = 0, ZK = 512, ZV = 1024, ZU = 1536, ZQM = 1792;

constexpr size_t MiB = 1u << 20;
constexpr size_t WS_CTL = 0, CTL_ZERO_BYTES = 1 * MiB;
constexpr size_t WS_RS = 1 * MiB;
constexpr size_t WS_RSTD = 1 * MiB + 128 * 1024;
constexpr size_t WS_SSQ = 2 * MiB;
constexpr size_t WS_WIN = 4 * MiB;
constexpr size_t WS_WOUT = 8 * MiB;
constexpr size_t WS_RT = 10 * MiB;
constexpr size_t WS_KVM = 11 * MiB;
constexpr size_t WS_TOKPOS = 12 * MiB;
constexpr size_t WS_ROWTOK = 13 * MiB;
constexpr size_t WS_ROWGATE = 21 * MiB;
constexpr size_t WS_LP = 29 * MiB;
constexpr size_t WS_ROWRSTD = 50 * MiB;
constexpr size_t WS_XB = 480 * MiB;
constexpr size_t WS_XG = 480 * MiB;
constexpr size_t WS_Z = 416 * MiB;
constexpr size_t WS_W13 = 416 * MiB;
constexpr size_t WS_YB = 416 * MiB;
constexpr size_t WS_MIX = 384 * MiB;
constexpr size_t WS_W2 = 304 * MiB;
constexpr size_t WS_PO = 336 * MiB;
constexpr size_t WS_X1Q = 336 * MiB;
constexpr size_t WS_HMID = 356 * MiB;
constexpr size_t WS_END = 512 * MiB;
constexpr int CW_CNT = 16384, CNT_STRIDE = 64;
constexpr int CW_BAR = 4096;

constexpr int RING_BYTES = 131072;
constexpr int WSCR_OFF = RING_BYTES;
constexpr int TAB_OFF = WSCR_OFF + 2048;
constexpr int LDSCTL_OFF = TAB_OFF + 2048, MISC_OFF = LDSCTL_OFF;
constexpr int RSC_OFF = LDSCTL_OFF + 1024;
constexpr int LDS_BYTES = 147456;
constexpr int RTK_OFF = RSC_OFF + 3072;
constexpr int GZ_OFF = RTK_OFF + 2048;
static_assert(GZ_OFF + 768 <= LDS_BYTES, "LDS map");

#define RLX_AGENT __ATOMIC_RELAXED, __HIP_MEMORY_SCOPE_AGENT
#define LDS_WAIT() asm volatile("s_waitcnt lgkmcnt(0)" ::: "memory")
#define VM_WAIT() asm volatile("s_waitcnt vmcnt(0)" ::: "memory")
__device__ __forceinline__ unsigned f2bf(float f) { unsigned u = __builtin_bit_cast(unsigned, f); return (u + 0x7fffu + ((u >> 16) & 1u)) >> 16; }
__device__ __forceinline__ unsigned pk2(float lo, float hi) { f32x2 v = {lo, hi}; bf16x2_t b = __builtin_convertvector(v, bf16x2_t); return __builtin_bit_cast(unsigned, b); }
__device__ __forceinline__ unsigned pk4f8(float a, float b, float c, float d) {
    a = __builtin_amdgcn_fmed3f(a, -F8MAX, F8MAX); b = __builtin_amdgcn_fmed3f(b, -F8MAX, F8MAX); c = __builtin_amdgcn_fmed3f(c, -F8MAX, F8MAX); d = __builtin_amdgcn_fmed3f(d, -F8MAX, F8MAX);
    int w = 0; w = __builtin_amdgcn_cvt_pk_fp8_f32(a, b, w, false); w = __builtin_amdgcn_cvt_pk_fp8_f32(c, d, w, true); return (unsigned)w; }
__device__ __forceinline__ v8i cat8(bf16x8 a, bf16x8 b) { const v4i x = __builtin_bit_cast(v4i, a), y = __builtin_bit_cast(v4i, b); return __builtin_shufflevector(x, y, 0, 1, 2, 3, 4, 5, 6, 7); }
__device__ __forceinline__ float bf2f(unsigned short h) { return __builtin_bit_cast(float, (unsigned)h << 16); }
__device__ __forceinline__ float bflo(unsigned w) { return __builtin_bit_cast(float, w << 16); }
__device__ __forceinline__ float bfhi(unsigned w) { return __builtin_bit_cast(float, w & 0xffff0000u); }
__device__ __forceinline__ float wave_sum(float v) {
#pragma unroll
    for (int o = 1; o < 64; o <<= 1) v += __shfl_xor(v, o);
    return v;
}
__device__ __forceinline__ int crow(int r, int hi) { return (r & 3) + 8 * (r >> 2) + 4 * hi; }

namespace pg8 {
constexpr int BM = 256, BK = 64, HALF = 128, HTB = HALF * BK * 2, NXCD = 8, WGM = 8;
__host__ __device__ __forceinline__ int lds_byte(int r, int c) { const int st = (r >> 4) * 2 + (c >> 5), rr = r & 15, cc = c & 31, ob = rr * 64 + cc * 2; return st * 1024 + (ob ^ (((ob >> 9) & 1) << 5)); }
__host__ __device__ __forceinline__ void stage_rc(int b, int& R, int& C) { const int st = b / 1024, sb = b % 1024, swz = sb ^ (((sb >> 9) & 1) << 5); R = (st >> 1) * 16 + swz / 64; C = (st & 1) * 32 + (swz % 64) / 2; }
__host__ __device__ __forceinline__ int perm32(int rho) { const int n = rho >> 4, i = rho & 15; return 8 * (i >> 2) + 4 * n + (i & 3); }

struct Unit { int pm, pn, e, mt, cnt, light; };
struct Gemm { const bf16* A; const bf16* Bt; int K; };

struct StaticOrder {
    int nM, nN, nwg, G, c;
    __device__ void init(int M, int N, int G_, int c_) { nM = M / BM; nN = N / BM; nwg = nM * nN; G = G_; c = c_; }
    __device__ bool next(int i, Unit& u) const {
        const long L = (long)i * G + c; if (L >= nwg) return false;
        int wgid = (int)L; { const int q = nwg / NXCD, r = nwg % NXCD, xcd = wgid % NXCD, off = wgid / NXCD; wgid = (xcd < r ? xcd * (q + 1) : r * (q + 1) + (xcd - r) * q) + off; }
        const int nig = WGM * nN, gid = wgid / nig, fm = gid * WGM, gsz = (nM - fm) < WGM ? (nM - fm) : WGM;
        u.pm = fm + ((wgid % nig) % gsz); u.pn = (wgid % nig) / gsz; u.e = 0; u.mt = 0; u.cnt = 0; u.light = 0; return true;
    }
    __device__ __forceinline__ int row(const Unit&, int) const { return 0; }
    __device__ __forceinline__ int row_lds(const Unit&, int, const LAS unsigned*) const { return 0; }
    __device__ __forceinline__ const unsigned* rtk_src(const Unit&) const { return nullptr; }
};
struct GroupOrder {
    const LAS int* tab;
    const unsigned* rowtok;
    int G, c;
    __device__ bool next(int i, Unit& u) const {
        const int NUH = tab[129 + 64] * 4, NUL = tab[194 + 64] * 4; long L = (long)i * G + c; if (L >= NUH + NUL) return false;
        const int lt = L >= NUH; const int NU = lt ? NUL : NUH; int wgid = (int)(lt ? L - NUH : L);
        { const int q = NU / NXCD, r = NU % NXCD, xcd = wgid % NXCD, off = wgid / NXCD; wgid = (xcd < r ? xcd * (q + 1) : r * (q + 1) + (xcd - r) * q) + off; }
        const int xt = wgid >> 2, pnl = wgid & 3, base = lt ? 194 : 129; int lo = 0;
#pragma unroll
        for (int st = 32; st >= 1; st >>= 1) { if (tab[base + lo + st] <= xt) lo += st; }
        const int ts = tab[64 + lo], ntl = tab[64 + lo + 1] - ts, mt = lt ? ntl - 1 : xt - tab[129 + lo];
        u.pm = ts + mt; u.pn = lo * 4 + pnl; u.e = lo; u.mt = mt; u.cnt = tab[lo]; u.light = lt; return true;
    }
    __device__ __forceinline__ int row(const Unit& u, int rl) const { const int idx = u.mt * 256 + rl; return idx < u.cnt ? (int)rowtok[(size_t)u.e * CAP + idx] : T; }
    __device__ __forceinline__ int row_lds(const Unit& u, int rl, const LAS unsigned* rt) const { const int idx = u.mt * 256 + rl; const int v = (int)rt[rl]; return idx < u.cnt ? v : T; }
    __device__ __forceinline__ const unsigned* rtk_src(const Unit& u) const { return rowtok + (size_t)u.e * CAP + u.mt * 256; }
};

template <class Epi, class Sched, bool GATHER, bool F8>
__device__ __forceinline__ void gemm_phase(LAS unsigned char* lds, const Gemm g, const Sched& S, const Epi& E) {
    const int tid = threadIdx.x, wid = __builtin_amdgcn_readfirstlane(tid >> 6), lane = tid & 63, wr = wid >> 2, wc = wid & 3, fr = lane & 15, fq = lane >> 4;
    const int K = g.K, nt = K / BK;
    unsigned voffA[2], voffB[2]; int RA[2], CA[2];
#pragma unroll
    for (int i = 0; i < 2; ++i) { int R, C; stage_rc(tid * 16 + i * 8192, R, C); const int Rb = Epi::PERM ? ((R & ~31) + perm32(R & 31)) : R;
        voffA[i] = (unsigned)(R * K + C) * 2u; voffB[i] = (unsigned)(Rb * K + C) * 2u; RA[i] = R; CA[i] = C; }
    const size_t kstep = (size_t)(BK * 2);
    const size_t hstep = (size_t)HALF * K * 2;
    const size_t tstep = 2 * hstep;
    const unsigned ldsw = (unsigned)wid * 1024u;
    const int aoff = lds_byte(wr * 64 + fr, fq * 8), boff = lds_byte(wc * 32 + fr, fq * 8);
    const char* gAb = (const char*)g.A;
    unsigned goff[2][2];
#define PG8_SA(b, h) (((b) * 2 + (h)) * HTB)
#define PG8_SB(b, h) ((4 + (b) * 2 + (h)) * HTB)
#define PG8_STAGE(bufoff, gbase, voff) do { _Pragma("unroll") for (int _i = 0; _i < 2; ++_i) \
        __builtin_amdgcn_global_load_lds((const unsigned*)((const char*)(gbase) + (voff)[_i]), (LAS unsigned*)(lds + (bufoff) + ldsw + _i * 8192), 16, 0, 0); } while (0)
#define PG8_STAGE_A(bufoff, h, base, kb) do { if constexpr (GATHER) { PG8_STAGE(bufoff, gAb + (kb), goff[h]); } else { PG8_STAGE(bufoff, (base) + (size_t)(h) * hstep + (kb), voffA); } } while (0)
#define PG8_SETG(u) do { if constexpr (GATHER) { _Pragma("unroll") for (int _h = 0; _h < 2; ++_h) _Pragma("unroll") for (int _i = 0; _i < 2; ++_i) \
        goff[_h][_i] = ((unsigned)S.row(u, _h * HALF + RA[_i]) * (unsigned)K + (unsigned)CA[_i]) * 2u; } } while (0)
#define PG8_SETG_LDS(u, slot) do { if constexpr (GATHER) { const LAS unsigned* rt_ = (const LAS unsigned*)(lds + RTK_OFF + (slot) * 1024); _Pragma("unroll") for (int _h = 0; _h < 2; ++_h) _Pragma("unroll") for (int _i = 0; _i < 2; ++_i) \
        goff[_h][_i] = ((unsigned)S.row_lds(u, _h * HALF + RA[_i], rt_) * (unsigned)K + (unsigned)CA[_i]) * 2u; } } while (0)
#define PG8_RTK(u, slot) do { if constexpr (GATHER) { if (wid == 1) { const unsigned* rp_ = S.rtk_src(u); unsigned keep_; const unsigned dst_ = (unsigned)(uintptr_t)(lds + RTK_OFF + (slot) * 1024); \
        asm volatile("s_mov_b32 %0, m0\n\ts_mov_b32 m0, %2\n\ts_nop 0\n\tglobal_load_lds_dwordx4 %1, off\n\ts_mov_b32 m0, %0" : "=&s"(keep_) : "v"(rp_ + lane * 4), "s"(dst_) : "memory"); } } } while (0)
#define PG8_LDA(dst, b, h) do { _Pragma("unroll") for (int m = 0; m < 4; ++m) dst[m] = cat8(*(const LAS bf16x8*)(lds + PG8_SA(b, h) + aoff + m * 2048), *(const LAS bf16x8*)(lds + PG8_SA(b, h) + aoff + m * 2048 + 1024)); } while (0)
#define PG8_LDB(dst, b, h) do { _Pragma("unroll") for (int n = 0; n < 2; ++n) dst[n] = cat8(*(const LAS bf16x8*)(lds + PG8_SB(b, h) + boff + n * 2048), *(const LAS bf16x8*)(lds + PG8_SB(b, h) + boff + n * 2048 + 1024)); } while (0)
#define PG8_LO(x) __builtin_bit_cast(bf16x8, __builtin_shufflevector(x, x, 0, 1, 2, 3))
#define PG8_HI(x) __builtin_bit_cast(bf16x8, __builtin_shufflevector(x, x, 4, 5, 6, 7))
#define PG8_MMA(ai, bj, At, Bt) do { __builtin_amdgcn_s_setprio(1); _Pragma("unroll") for (int m = 0; m < 4; ++m) _Pragma("unroll") for (int n = 0; n < 2; ++n) { \
        if constexpr (F8) asm volatile("v_mfma_f32_16x16x128_f8f6f4 %0, %1, %2, %0" : "+v"(acc[ai][bj][m][n]) : "v"(Bt[n]), "v"(At[m])); \
        else { acc[ai][bj][m][n] = __builtin_amdgcn_mfma_f32_16x16x32_bf16(PG8_LO(Bt[n]), PG8_LO(At[m]), acc[ai][bj][m][n], 0, 0, 0); \
               acc[ai][bj][m][n] = __builtin_amdgcn_mfma_f32_16x16x32_bf16(PG8_HI(Bt[n]), PG8_HI(At[m]), acc[ai][bj][m][n], 0, 0, 0); } } __builtin_amdgcn_s_setprio(0); } while (0)
#define PG8_WAIT_V(n) asm volatile("s_waitcnt vmcnt(" #n ")" ::: "memory")
#define PG8_WAIT_L(n) asm volatile("s_waitcnt lgkmcnt(" #n ")" ::: "memory")
#define PG8_BAR __builtin_amdgcn_s_barrier()
#define PG8_SCHED __builtin_amdgcn_sched_barrier(0)
    Unit cur, nxt; int ui = 0;
    if (!S.next(0, cur)) return;
#define PG8_RSC(u, slot) do { if (wid == 0) { const float* rp_ = E.rsc_src(u); if (rp_) { unsigned keep_; const unsigned dst_ = (unsigned)(uintptr_t)(lds + RSC_OFF + (slot) * 1024); \
        asm volatile("s_mov_b32 %0, m0\n\ts_mov_b32 m0, %2\n\ts_nop 0\n\tglobal_load_lds_dwordx4 %1, off\n\ts_mov_b32 m0, %0" : "=&s"(keep_) : "v"(rp_ + lane * 4), "s"(dst_) : "memory"); } } } while (0)
    PG8_RSC(cur, 0);
    f32x4 acc[2][2][4][2];
#pragma unroll
    for (int a = 0; a < 2; ++a)
#pragma unroll
        for (int b = 0; b < 2; ++b)
#pragma unroll
            for (int m = 0; m < 4; ++m)
#pragma unroll
                for (int n = 0; n < 2; ++n) acc[a][b][m][n] = (f32x4){0.f, 0.f, 0.f, 0.f};
    v8i At[4], B0[2], B1[2];
    const char* cA = (const char*)g.A + (size_t)cur.pm * tstep; const char* cB = (const char*)g.Bt + (size_t)cur.pn * tstep;
    PG8_SETG(cur);
    PG8_STAGE(PG8_SB(0, 0), cB, voffB); PG8_STAGE(PG8_SB(0, 1), cB + hstep, voffB); PG8_STAGE_A(PG8_SA(0, 0), 0, cA, 0); PG8_STAGE_A(PG8_SA(0, 1), 1, cA, 0);
    if (wr == 1) PG8_BAR;
    PG8_WAIT_V(2); PG8_BAR;
    PG8_STAGE(PG8_SB(1, 0), cB + kstep, voffB); PG8_STAGE_A(PG8_SA(1, 0), 0, cA, kstep); PG8_STAGE(PG8_SB(1, 1), cB + hstep + kstep, voffB);
    PG8_WAIT_V(6); PG8_BAR;
    for (;;) {
        const bool has_next = S.next(ui + 1, nxt);
        if (has_next) { PG8_RSC(nxt, (ui + 1) % 3); PG8_RTK(nxt, (ui + 1) & 1); }
        const char* nA = has_next ? (const char*)g.A + (size_t)nxt.pm * tstep : cA; const char* nB = has_next ? (const char*)g.Bt + (size_t)nxt.pn * tstep : cB;
#pragma unroll 1
        for (int t = 0; t < nt; t += 2) {
            const bool last = (t == nt - 2);
            const size_t k1 = (size_t)(t + 1) * kstep, k2 = last ? 0 : (size_t)(t + 2) * kstep, k3 = k2 + kstep;
            const char* pa2 = last ? nA : cA; const char* pb2 = last ? nB : cB;
            PG8_LDB(B0, 0, 0); PG8_LDB(B1, 0, 1); PG8_SCHED; PG8_LDA(At, 0, 0); PG8_STAGE_A(PG8_SA(1, 1), 1, cA, k1);
            if constexpr (GATHER) { if (last && has_next) PG8_SETG_LDS(nxt, (ui + 1) & 1); }
            PG8_WAIT_V(8); PG8_WAIT_L(0); PG8_BAR; PG8_MMA(0, 0, At, B0); PG8_MMA(0, 1, At, B1); PG8_BAR; PG8_SCHED;
            if (!cur.light) PG8_LDA(At, 0, 1); PG8_STAGE(PG8_SB(0, 0), pb2 + k2, voffB); PG8_STAGE(PG8_SB(0, 1), pb2 + hstep + k2, voffB); PG8_STAGE_A(PG8_SA(0, 0), 0, pa2, k2);
            PG8_WAIT_V(8); PG8_WAIT_L(0); PG8_BAR; if (!cur.light) { PG8_MMA(1, 0, At, B0); PG8_MMA(1, 1, At, B1); } PG8_BAR; PG8_SCHED;
            PG8_LDB(B0, 1, 0); PG8_LDB(B1, 1, 1); PG8_SCHED; PG8_LDA(At, 1, 0); PG8_STAGE_A(PG8_SA(0, 1), 1, pa2, k2);
            PG8_WAIT_V(8); PG8_WAIT_L(0); PG8_BAR; PG8_MMA(0, 0, At, B0); PG8_MMA(0, 1, At, B1); PG8_BAR; PG8_SCHED;
            if (!cur.light) PG8_LDA(At, 1, 1); PG8_STAGE(PG8_SB(1, 0), pb2 + k3, voffB); PG8_STAGE(PG8_SB(1, 1), pb2 + hstep + k3, voffB); PG8_STAGE_A(PG8_SA(1, 0), 0, pa2, k3);
            PG8_WAIT_V(8); PG8_WAIT_L(0); PG8_BAR; if (!cur.light) { PG8_MMA(1, 0, At, B0); PG8_MMA(1, 1, At, B1); } PG8_BAR; PG8_SCHED;
        }
        if constexpr (F8) { asm volatile("s_nop 15\n\ts_nop 15" ::: "memory"); PG8_SCHED; }
        if (wr == 0) PG8_BAR;
        E(acc, cur, wr, wc, fr, fq, (const LAS float*)(lds + RSC_OFF + (ui % 3) * 1024));
        if (!has_next) break;
#pragma unroll
        for (int a = 0; a < 2; ++a)
#pragma unroll
            for (int b = 0; b < 2; ++b)
#pragma unroll
                for (int m = 0; m < 4; ++m)
#pragma unroll
                    for (int n = 0; n < 2; ++n) acc[a][b][m][n] = (f32x4){0.f, 0.f, 0.f, 0.f};
        cur = nxt; cA = nA; cB = nB; ++ui;
        if (wr == 1) PG8_BAR;
    }
    PG8_WAIT_V(0);
    PG8_BAR;
#undef PG8_SA
#undef PG8_SB
#undef PG8_STAGE
#undef PG8_STAGE_A
#undef PG8_SETG
#undef PG8_SETG_LDS
#undef PG8_RTK
#undef PG8_LDA
#undef PG8_LDB
#undef PG8_RSC
#undef PG8_LO
#undef PG8_HI
#undef PG8_MMA
#undef PG8_WAIT_V
#undef PG8_WAIT_L
#undef PG8_BAR
#undef PG8_SCHED
}

struct EpiZ {
    static constexpr bool PERM = true;
    bf16* Z; const float* rs; const LAS float* gz;
    __device__ __forceinline__ const float* rsc_src(const Unit& u) const { return rs + (size_t)u.pm * BM; }
    __device__ __forceinline__ void operator()(const f32x4 (&acc)[2][2][4][2], const Unit& u, int wr, int wc, int fr, int fq, const LAS float* rsc) const {
        const int pn = u.pn;
        const LAS float* gp = pn < 2 ? gz : (pn < 4 ? gz + 64 : (pn == 7 ? gz + 128 : nullptr));
        f32x4 gv[2][2];
#pragma unroll
        for (int bj = 0; bj < 2; ++bj)
#pragma unroll
            for (int n = 0; n < 2; ++n) gv[bj][n] = gp ? *(const LAS f32x4*)(gp + 32 * bj + 8 * fq + 4 * n) : (f32x4){1.f, 1.f, 1.f, 1.f};
        const int col0 = 256 * pn + 64 * wc + 8 * fq;
#pragma unroll
        for (int ai = 0; ai < 2; ++ai)
#pragma unroll
            for (int m = 0; m < 4; ++m) {
                const int rl = ai * HALF + wr * 64 + m * 16 + fr, row = u.pm * BM + rl; const float r = rsc[rl];
                f32x4 v[2][2]; float ss = 0.f;
#pragma unroll
                for (int bj = 0; bj < 2; ++bj)
#pragma unroll
                    for (int n = 0; n < 2; ++n) { v[bj][n] = acc[ai][bj][m][n] * r; const f32x4 q = v[bj][n] * v[bj][n]; ss += (q[0] + q[1]) + (q[2] + q[3]); }
                if (gp) { ss += __shfl_xor(ss, 16); ss += __shfl_xor(ss, 32); const float rn = 1.0f / sqrtf(ss * (1.f / 64.f) + EPS);
#pragma unroll
                    for (int bj = 0; bj < 2; ++bj)
#pragma unroll
                        for (int n = 0; n < 2; ++n) v[bj][n] = v[bj][n] * rn * gv[bj][n]; }
                bf16* rowp = Z + ((size_t)(4 * pn + wc) * T + row) * 64 + 8 * fq;
#pragma unroll
                for (int bj = 0; bj < 2; ++bj) { u32x4 w; w.x = pk2(v[bj][0][0], v[bj][0][1]); w.y = pk2(v[bj][0][2], v[bj][0][3]); w.z = pk2(v[bj][1][0], v[bj][1][1]); w.w = pk2(v[bj][1][2], v[bj][1][3]);
                    *(u32x4*)(rowp + 32 * bj) = w; }
            }
    }
};
struct EpiX1 {
    static constexpr bool PERM = true;
    const bf16* xb; bf16* x1b; float* ssq;
    __device__ __forceinline__ const float* rsc_src(const Unit&) const { return nullptr; }
    __device__ __forceinline__ void operator()(const f32x4 (&acc)[2][2][4][2], const Unit& u, int wr, int wc, int fr, int fq, const LAS float*) const {
        const int col0 = u.pn * BM + wc * 32 + 8 * fq;
#pragma unroll
        for (int ai = 0; ai < 2; ++ai)
#pragma unroll
            for (int m = 0; m < 4; ++m) {
                const int row = u.pm * BM + ai * HALF + wr * 64 + m * 16 + fr; const size_t off = (size_t)row * DM + col0; float ss = 0.f;
#pragma unroll
                for (int bj = 0; bj < 2; ++bj) { f32x4 x1[2]; const u32x4 xw = *(const u32x4*)(xb + off + bj * HALF);
                    x1[0] = (f32x4){bflo(xw.x), bfhi(xw.x), bflo(xw.y), bfhi(xw.y)} + acc[ai][bj][m][0]; x1[1] = (f32x4){bflo(xw.z), bfhi(xw.z), bflo(xw.w), bfhi(xw.w)} + acc[ai][bj][m][1];
#pragma unroll
                    for (int n = 0; n < 2; ++n) { const f32x4 q = x1[n] * x1[n]; ss += (q[0] + q[1]) + (q[2] + q[3]); }
                    u32x4 w; w.x = pk2(x1[0][0], x1[0][1]); w.y = pk2(x1[0][2], x1[0][3]); w.z = pk2(x1[1][0], x1[1][1]); w.w = pk2(x1[1][2], x1[1][3]);
                    *(u32x4*)(x1b + off + bj * HALF) = w; }
                ss += __shfl_xor(ss, 16); ss += __shfl_xor(ss, 32);
                if (fq == 0) ssq[(size_t)row * 16 + u.pn * 4 + wc] = ss;
            }
    }
};
struct EpiH {
    static constexpr bool PERM = true;
    unsigned char* H; const float* rowrstd;
    __device__ __forceinline__ const float* rsc_src(const Unit& u) const { return rowrstd + (size_t)u.e * CAP + u.mt * 256; }
    __device__ __forceinline__ void operator()(const f32x4 (&acc)[2][2][4][2], const Unit& u, int wr, int wc, int fr, int fq, const LAS float* rsc) const {
        const int pnl = u.pn & 3, col0 = 128 * pnl + 32 * wc + 8 * fq;
#pragma unroll
        for (int ai = 0; ai < 2; ++ai) { if (ai == 1 && u.light) break;
#pragma unroll
            for (int m = 0; m < 4; ++m) {
                const int rl = ai * HALF + wr * 64 + m * 16 + fr, idx = u.mt * 256 + rl; const bool valid = idx < u.cnt;
                const float rs = valid ? rsc[rl] * (1.0f / W13_SCALE) : 0.f;
                float h[8];
#pragma unroll
                for (int n = 0; n < 2; ++n)
#pragma unroll
                    for (int e = 0; e < 4; ++e) { const float a = acc[ai][0][m][n][e] * rs, b = acc[ai][1][m][n][e] * rs;
                        const float sg = __builtin_amdgcn_rcpf(1.0f + __builtin_amdgcn_exp2f(-1.4426950408889634f * a)); h[4 * n + e] = a * sg * b * H_SCALE; }
                u32x2 w; w.x = pk4f8(h[0], h[1], h[2], h[3]); w.y = pk4f8(h[4], h[5], h[6], h[7]);
                *(u32x2*)(H + (size_t)(u.pm * BM + rl) * EH + col0) = w;
            } }
    }
};
struct EpiY {
    static constexpr bool PERM = true;
    bf16* Y; const float* rowgate; const LAS int* tab;
    __device__ __forceinline__ const float* rsc_src(const Unit& u) const { return rowgate + (size_t)u.e * CAP + u.mt * 256; }
    __device__ __forceinline__ void operator()(const f32x4 (&acc)[2][2][4][2], const Unit& u, int wr, int wc, int fr, int fq, const LAS float* rsc) const {
        const int pnl = u.pn & 3, col0 = 256 * pnl + 32 * wc + 8 * fq;
#pragma unroll
        for (int ai = 0; ai < 2; ++ai) { if (ai == 1 && u.light) break;
#pragma unroll
            for (int m = 0; m < 4; ++m) {
                const int rl = ai * HALF + wr * 64 + m * 16 + fr, idx = u.mt * 256 + rl; const bool valid = idx < u.cnt;
                const float gt = valid ? rsc[rl] * (1.0f / (W2_SCALE * H_SCALE)) : 0.f;
                if (!valid) continue;
                bf16* rowp = Y + (size_t)(tab[259 + u.e] + idx) * DM + col0;
#pragma unroll
                for (int bj = 0; bj < 2; ++bj) { const f32x4 v0 = acc[ai][bj][m][0] * gt, v1 = acc[ai][bj][m][1] * gt;
                    u32x4 w; w.x = pk2(v0[0], v0[1]); w.y = pk2(v0[2], v0[3]); w.z = pk2(v1[0], v1[1]); w.w = pk2(v1[2], v1[3]); *(u32x4*)(rowp + bj * HALF) = w; }
            } }
    }
};
}

#define XB_TMO      128
#define XB_XCNT(j)  (256  + 64 * (j))
#define XB_XSUB(j)  (1280 + 64 * (j))
#define XB_XGEN(j)  (2304 + 64 * (j))
#define XB_TOP      3328
#define XB_TOPGEN   3392
#define XCD_BAR_WORDS 3456
#define XB_SPIN_CAP (1u << 18)
__device__ __forceinline__ unsigned xb_ld(unsigned* p)              { return __hip_atomic_load(p, __ATOMIC_RELAXED, __HIP_MEMORY_SCOPE_AGENT); }
__device__ __forceinline__ unsigned xb_add(unsigned* p, unsigned v) { return __hip_atomic_fetch_add(p, v, __ATOMIC_RELAXED, __HIP_MEMORY_SCOPE_AGENT); }
__device__ __forceinline__ unsigned xb_xcc_id() { return (unsigned)__builtin_amdgcn_s_getreg((3 << 11) | 20) & 0xFu; }
#define XB_SPIN(cond, bar) do { unsigned _sp = 0; while (cond) { __builtin_amdgcn_s_sleep(1); \
    if ((++_sp & 255u) == 0u) { if (xb_ld(&(bar)[XB_TMO])) break; if (_sp > XB_SPIN_CAP) { atomicAdd(&(bar)[XB_TMO], 1u); break; } } } } while (0)
struct XcdBarrier { unsigned* bar; unsigned x; volatile LAS unsigned* st; };
__device__ __forceinline__ XcdBarrier xcd_barrier_post(unsigned* bar, volatile LAS unsigned* st) {
    XcdBarrier b; b.bar = bar; b.x = xb_xcc_id(); b.st = st;
    if (threadIdx.x == 0) (void)xb_add(&bar[XB_XCNT(b.x)], 1u);
    return b;
}
__device__ __forceinline__ void xcd_barrier_complete(unsigned* bar, unsigned x, unsigned& nloc, unsigned& nx) {
    const unsigned G = gridDim.x * gridDim.y * gridDim.z;
    unsigned sum, cnt, mine, sp = 0u;
    for (;;) {
        sum = 0u; cnt = 0u; mine = 0u;
#pragma unroll
        for (unsigned j = 0; j < 16; ++j) { const unsigned c = xb_ld(&bar[XB_XCNT(j)]); sum += c; cnt += (c > 0u) ? 1u : 0u; mine = (j == x) ? c : mine; }
        if (sum == G) break;
        __builtin_amdgcn_s_sleep(1);
        if ((++sp & 255u) == 0u) { if (xb_ld(&bar[XB_TMO])) break; if (sp > XB_SPIN_CAP) { atomicAdd(&bar[XB_TMO], 1u); break; } }
    }
    nloc = mine > 0u ? mine : 1u; nx = cnt > 0u ? cnt : 1u;
}
__device__ __forceinline__ void xcd_barrier(const XcdBarrier& b) {
    asm volatile("s_waitcnt vmcnt(0)" ::: "memory");
    __syncthreads();
    if (threadIdx.x == 0) {
        unsigned* bar = b.bar;
        __builtin_amdgcn_s_waitcnt(0);
        unsigned nloc = b.st[0], nx = b.st[1];
        if (nloc == 0u) { xcd_barrier_complete(bar, b.x, nloc, nx); b.st[0] = nloc; b.st[1] = nx; }
        const unsigned old = xb_add(&bar[XB_XSUB(b.x)], 1u);
        const unsigned gen = old / nloc;
        if (old + 1u == (gen + 1u) * nloc) {
            __builtin_amdgcn_fence(__ATOMIC_RELEASE, "agent");
            asm volatile("s_waitcnt vmcnt(0)" ::: "memory");
            const unsigned og = xb_add(&bar[XB_TOP], 1u);
            const unsigned tg = og / nx;
            if (og + 1u == (tg + 1u) * nx) xb_add(&bar[XB_TOPGEN], 1u);
            else XB_SPIN(xb_ld(&bar[XB_TOPGEN]) == tg, bar);
            __builtin_amdgcn_fence(__ATOMIC_ACQUIRE, "agent");
            xb_add(&bar[XB_XGEN(b.x)], 1u);
            asm volatile("s_waitcnt vmcnt(0)" ::: "memory");
        } else {
            XB_SPIN(xb_ld(&bar[XB_XGEN(b.x)]) == gen, bar);
            __builtin_amdgcn_fence(__ATOMIC_ACQUIRE, "agent");
            asm volatile("s_waitcnt vmcnt(0)" ::: "memory");
        }
    }
    __syncthreads();
}

struct XbTicket { unsigned last, gen, tg; };
__device__ __forceinline__ XbTicket xcd_barrier_arrive(const XcdBarrier& b) {
    asm volatile("s_waitcnt vmcnt(0)" ::: "memory");
    __syncthreads();
    XbTicket t; t.last = 0u; t.gen = 0u; t.tg = 0u;
    if (threadIdx.x == 0) {
        unsigned* bar = b.bar;
        __builtin_amdgcn_s_waitcnt(0);
        unsigned nloc = b.st[0], nx = b.st[1];
        if (nloc == 0u) { xcd_barrier_complete(bar, b.x, nloc, nx); b.st[0] = nloc; b.st[1] = nx; }
        const unsigned old = xb_add(&bar[XB_XSUB(b.x)], 1u);
        t.gen = old / nloc;
        if (old + 1u == (t.gen + 1u) * nloc) {
            t.last = 1u;
            __builtin_amdgcn_fence(__ATOMIC_RELEASE, "agent");
            asm volatile("s_waitcnt vmcnt(0)" ::: "memory");
            const unsigned og = xb_add(&bar[XB_TOP], 1u);
            t.tg = og / nx;
            if (og + 1u == (t.tg + 1u) * nx) { xb_add(&bar[XB_TOPGEN], 1u); t.last = 2u; }
        }
    }
    return t;
}
__device__ __forceinline__ void xcd_barrier_wait(const XcdBarrier& b, const XbTicket& t) {
    asm volatile("s_waitcnt vmcnt(0)" ::: "memory");
    if (threadIdx.x == 0) {
        unsigned* bar = b.bar;
        if (t.last != 0u) {
            if (t.last == 1u) XB_SPIN(xb_ld(&bar[XB_TOPGEN]) == t.tg, bar);
            __builtin_amdgcn_fence(__ATOMIC_ACQUIRE, "agent");
            xb_add(&bar[XB_XGEN(b.x)], 1u);
            asm volatile("s_waitcnt vmcnt(0)" ::: "memory");
        } else {
            XB_SPIN(xb_ld(&bar[XB_XGEN(b.x)]) == t.gen, bar);
            __builtin_amdgcn_fence(__ATOMIC_ACQUIRE, "agent");
            asm volatile("s_waitcnt vmcnt(0)" ::: "memory");
        }
    }
    __syncthreads();
}

struct Args { const float* in[21]; float* out; unsigned char* ws; unsigned char* wsh; int ph_lo, ph_hi; };
struct Frame {
    LAS unsigned char* lds; int tid, lane, wave, vcu, G;
    const float* in[21]; float* out; unsigned char* ws; unsigned char* wsh;
};

__device__ __forceinline__ void p0_item(const float* W, int N, const float* gain, int k0, int n0, bf16* WT, int Kd, size_t drow0, LAS float* scr, int lane) {
#pragma unroll 8
    for (int i = 0; i < 32; ++i) { const int kk = 2 * i + (lane >> 5); float v = __builtin_nontemporal_load(W + (size_t)(k0 + kk) * N + n0 + (lane & 31)); if (gain) v *= gain[k0 + kk]; scr[kk * 33 + (lane & 31)] = v; }
    LDS_WAIT(); asm volatile("" ::: "memory");
    const int c = lane & 7;
#pragma unroll
    for (int j = 0; j < 4; ++j) { const int n = (lane >> 3) + 8 * j; const LAS float* s = scr + (8 * c) * 33 + n;
        u32x4 o; o.x = pk2(s[0 * 33], s[1 * 33]); o.y = pk2(s[2 * 33], s[3 * 33]); o.z = pk2(s[4 * 33], s[5 * 33]); o.w = pk2(s[6 * 33], s[7 * 33]);
        *(GAS u32x4*)(WT + (drow0 + n) * (size_t)Kd + k0 + 8 * c) = o; }
    LDS_WAIT(); asm volatile("" ::: "memory");
}
__device__ __forceinline__ void p0_poolfold_item(const float* Wout, const float* proj, const float* scale, int item, bf16* WT, int lane) {
    const int g = item >> 7, cb = (item >> 4) & 7, nb = item & 15, n = nb * 64 + lane, c0 = cb * 8;
    float acc[8];
#pragma unroll
    for (int j = 0; j < 8; ++j) acc[j] = 0.f;
    const float* pr = proj + (size_t)(g * 64 + c0) * 64;
#pragma unroll 8
    for (int e = 0; e < 64; ++e) { const float wo = Wout[(size_t)(512 + 64 * g + e) * DM + n] * scale[64 * g + e];
#pragma unroll
        for (int j = 0; j < 8; ++j) acc[j] += pr[j * 64 + e] * wo; }
    u32x4 o; o.x = pk2(acc[0], acc[1]); o.y = pk2(acc[2], acc[3]); o.z = pk2(acc[4], acc[5]); o.w = pk2(acc[6], acc[7]);
    *(GAS u32x4*)(WT + (size_t)n * DM + 512 + 64 * g + c0) = o;
}
__device__ __forceinline__ void p0_xrow(const float* xrow, bf16* orow, float* rs, int lane) {
    const GAS f32x4* xr = (const GAS f32x4*)xrow + lane;
    f32x4 v[4]; float s = 0.f;
#pragma unroll
    for (int j = 0; j < 4; ++j) { v[j] = xr[64 * j]; s += (v[j].x * v[j].x + v[j].y * v[j].y) + (v[j].z * v[j].z + v[j].w * v[j].w); }
    s = wave_sum(s);
    if (lane == 0) *rs = 1.0f / sqrtf(s * (1.f / DM) + EPS);
    GAS unsigned long long* o8 = (GAS unsigned long long*)orow + lane;
#pragma unroll
    for (int j = 0; j < 4; ++j) o8[64 * j] = (unsigned long long)pk2(v[j].x, v[j].y) | ((unsigned long long)pk2(v[j].z, v[j].w) << 32);
}
__device__ __forceinline__ void p0_memkv(Frame& F, int task, LAS float* myscr, LAS float* grpscr  ) {
    const float* mem = F.in[1]; const float* mnorm = F.in[8]; const float* wkv = F.in[9]; const float* mkn = F.in[11];
    bf16* kvm = (bf16*)(F.ws + WS_KVM);
    const int lane = F.lane, i = lane & 15, kk = lane >> 4, kq = F.wave & 3;
    const int rb = task >> 3, cb = task & 7, row = rb * 16 + i;
    f32x4 acc[4];
#pragma unroll
    for (int nb = 0; nb < 4; ++nb) acc[nb] = (f32x4){0.f, 0.f, 0.f, 0.f};
    float ss = 0.f;
    const float* arow = mem + (size_t)row * DM;
    const float* wb = wkv + cb * 64 + i;
#pragma unroll 2
    for (int st = 0; st < 8; ++st) {
        const int k0 = 256 * kq + 32 * st + 8 * kk;
        const f32x4 a0 = *(const f32x4*)(arow + k0), a1 = *(const f32x4*)(arow + k0 + 4), g0 = *(const f32x4*)(mnorm + k0), g1 = *(const f32x4*)(mnorm + k0 + 4);
        float bv[4][8];
#pragma unroll
        for (int nb = 0; nb < 4; ++nb)
#pragma unroll
            for (int j = 0; j < 8; ++j) bv[nb][j] = wb[(size_t)(k0 + j) * 512 + nb * 16];
        ss += ((a0[0] * a0[0] + a0[1] * a0[1]) + (a0[2] * a0[2] + a0[3] * a0[3])) + ((a1[0] * a1[0] + a1[1] * a1[1]) + (a1[2] * a1[2] + a1[3] * a1[3]));
        const f32x4 p0 = a0 * g0, p1 = a1 * g1;
        u32x4 aw; aw.x = pk2(p0[0], p0[1]); aw.y = pk2(p0[2], p0[3]); aw.z = pk2(p1[0], p1[1]); aw.w = pk2(p1[2], p1[3]);
        const bf16x8 a8 = __builtin_bit_cast(bf16x8, aw);
#pragma unroll
        for (int nb = 0; nb < 4; ++nb) { u32x4 bw; bw.x = pk2(bv[nb][0], bv[nb][1]); bw.y = pk2(bv[nb][2], bv[nb][3]); bw.z = pk2(bv[nb][4], bv[nb][5]); bw.w = pk2(bv[nb][6], bv[nb][7]);
            acc[nb] = __builtin_amdgcn_mfma_f32_16x16x32_bf16(a8, __builtin_bit_cast(bf16x8, bw), acc[nb], 0, 0, 0); }
    }
#pragma unroll
    for (int nb = 0; nb < 4; ++nb)
#pragma unroll
        for (int r = 0; r < 4; ++r) myscr[(nb * 4 + r) * 64 + lane] = acc[nb][r];
    myscr[1024 + lane] = ss;
    LDS_WAIT(); __syncthreads();
    if (kq == 0) {
        float ssum = 0.f;
#pragma unroll
        for (int w = 0; w < 4; ++w) ssum += grpscr[w * 4096 + 1024 + lane];
        ssum += __shfl_xor(ssum, 16); ssum += __shfl_xor(ssum, 32);
        const float rsm = 1.0f / sqrtf(ssum * (1.f / DM) + EPS);
        float v[4][4];
#pragma unroll
        for (int nb = 0; nb < 4; ++nb)
#pragma unroll
            for (int r = 0; r < 4; ++r) { float s = 0.f;
#pragma unroll
                for (int w = 0; w < 4; ++w) s += grpscr[w * 4096 + (nb * 4 + r) * 64 + lane];
                v[nb][r] = s; }
#pragma unroll
        for (int r = 0; r < 4; ++r) { const int rowD = 4 * kk + r; const float rr = __shfl(rsm, rowD);
#pragma unroll
            for (int nb = 0; nb < 4; ++nb) v[nb][r] *= rr; }
        if (cb < 4) {
#pragma unroll
            for (int r = 0; r < 4; ++r) { float s2 = 0.f;
#pragma unroll
                for (int nb = 0; nb < 4; ++nb) s2 += v[nb][r] * v[nb][r];
                s2 += __shfl_xor(s2, 1); s2 += __shfl_xor(s2, 2); s2 += __shfl_xor(s2, 4); s2 += __shfl_xor(s2, 8);
                const float rn = 1.0f / sqrtf(s2 * (1.f / 64.f) + EPS);
#pragma unroll
                for (int nb = 0; nb < 4; ++nb) v[nb][r] *= rn * mkn[nb * 16 + i]; }
        }
#pragma unroll
        for (int r = 0; r < 4; ++r)
#pragma unroll
            for (int nb = 0; nb < 4; ++nb) kvm[(size_t)(rb * 16 + 4 * kk + r) * 512 + cb * 64 + nb * 16 + i] = (bf16)f2bf(v[nb][r]);
    }
    __syncthreads();
}

__device__ __forceinline__ void p0_prologue(Frame& F) {
    LAS float* scr = (LAS float*)(F.lds + F.wave * 16384);
    const int gw = F.vcu * 8 + F.wave, NGW = F.G * 8;
    for (int t2 = F.vcu; t2 < 256; t2 += F.G) p0_memkv(F, t2 * 2 + (F.wave >> 2), scr, (LAS float*)(F.lds + (F.wave & 4) * 16384));
    const float* attn_norm = F.in[2]; const float* w_in = F.in[3]; const float* w_out = F.in[12];
    bf16* WinT = (bf16*)(F.ws + WS_WIN); bf16* WoutT = (bf16*)(F.ws + WS_WOUT);
    constexpr int I_IN = 16 * 64, I_OUT = 12 * 32, I_FOLD = 512;
    constexpr int NITEMS = I_IN + I_OUT + I_FOLD;
    for (int it = gw; it < NITEMS; it += NGW) {
        int r = it;
        if (r < I_IN) { const int kb = r >> 6, nb = r & 63, n0 = nb * 32;
            const int pn = n0 >> 8, wc = (n0 >> 6) & 3, bj = (n0 >> 5) & 1; const size_t drow = (size_t)(256 * pn + 128 * bj + 32 * wc);
            p0_item(w_in, INW, attn_norm, kb * 64, n0, WinT, DM, drow, scr, F.lane); continue; }
        r -= I_IN;
        if (r < I_OUT) { int kb = r >> 5; const int nb = r & 31; if (kb >= 8) kb += 4;
            p0_item(w_out, DM, nullptr, kb * 64, nb * 32, WoutT, DM, (size_t)nb * 32, scr, F.lane); continue; }
        r -= I_OUT;
        p0_poolfold_item(w_out, F.in[6], F.in[7], r, WoutT, F.lane);
    }
    { const float* x = F.in[0]; bf16* XB = (bf16*)(F.wsh + WS_XB); float* RS = (float*)(F.ws + WS_RS);
      for (int m = gw; m < T; m += 2 * NGW) {
          const int m2 = m + NGW; const bool has2 = m2 < T;
          const GAS f32x4* xa = (const GAS f32x4*)(x + (size_t)m * DM) + F.lane; const GAS f32x4* xb2 = (const GAS f32x4*)(x + (size_t)(has2 ? m2 : m) * DM) + F.lane;
          f32x4 va[4], vb[4]; float sa = 0.f, sb = 0.f;
#pragma unroll
          for (int j = 0; j < 4; ++j) { va[j] = __builtin_nontemporal_load(&xa[64 * j]); vb[j] = __builtin_nontemporal_load(&xb2[64 * j]); }
#pragma unroll
          for (int j = 0; j < 4; ++j) { sa += (va[j].x * va[j].x + va[j].y * va[j].y) + (va[j].z * va[j].z + va[j].w * va[j].w); sb += (vb[j].x * vb[j].x + vb[j].y * vb[j].y) + (vb[j].z * vb[j].z + vb[j].w * vb[j].w); }
          sa = wave_sum(sa); sb = wave_sum(sb);
          if (F.lane == 0) { RS[m] = 1.0f / sqrtf(sa * (1.f / DM) + EPS); if (has2) RS[m2] = 1.0f / sqrtf(sb * (1.f / DM) + EPS); }
          GAS unsigned long long* oa = (GAS unsigned long long*)(XB + (size_t)m * DM) + F.lane;
#pragma unroll
          for (int j = 0; j < 4; ++j) oa[64 * j] = (unsigned long long)pk2(va[j].x, va[j].y) | ((unsigned long long)pk2(va[j].z, va[j].w) << 32);
          if (has2) { GAS unsigned long long* ob = (GAS unsigned long long*)(XB + (size_t)m2 * DM) + F.lane;
#pragma unroll
              for (int j = 0; j < 4; ++j) ob[64 * j] = (unsigned long long)pk2(vb[j].x, vb[j].y) | ((unsigned long long)pk2(vb[j].z, vb[j].w) << 32); } } }
    { bf16* RT = (bf16*)(F.ws + WS_RT); const float* wg = F.in[14]; const float* wr = F.in[16];
      const int gt = F.vcu * 512 + F.tid, NGT = F.G * 512;
      for (int idx = gt; idx < 96 * 1024; idx += NGT) { const int j = idx >> 10, k = idx & 1023; float v = 0.f;
          if (j < 8) v = wg[k * 8 + j]; else if (j < 72) v = wr[(size_t)((j - 8) >> 3) * 8192 + k * 8 + ((j - 8) & 7)];
          RT[idx] = (bf16)f2bf(v * F.in[13][k]); }
    }
}

template <int NQ>
__device__ __forceinline__ void cv_item_f8(const float* W, int N, const float* gain, float scale, int k0, int n0, unsigned char* WT, int Kd, size_t drow0, LAS unsigned* scr, int lane) {
#pragma unroll 1
    for (int qt = 0; qt < NQ; ++qt) {
        const int kh = k0 + 64 * qt;
        const float* wp = W + (size_t)kh * N + n0 + lane;
        float v[64];
#pragma unroll
        for (int i = 0; i < 64; ++i) v[i] = __builtin_nontemporal_load(wp + (size_t)i * N);
        if (gain) {
#pragma unroll
            for (int i = 0; i < 64; ++i) v[i] *= gain[kh + i]; }
#pragma unroll
        for (int q = 0; q < 16; ++q) { const int kq = 16 * qt + q; scr[kq * 64 + (lane ^ (2 * (kq >> 2)))] = pk4f8(v[4 * q] * scale, v[4 * q + 1] * scale, v[4 * q + 2] * scale, v[4 * q + 3] * scale); }
    }
    LDS_WAIT(); asm volatile("" ::: "memory");
    constexpr int NC = 4 * NQ;
    const int c = lane % NC;
#pragma unroll
    for (int j = 0; j < NC; ++j) { const int n = lane / NC + (64 / NC) * j; const LAS unsigned* sp = scr + (4 * c) * 64 + (n ^ (2 * c));
        u32x4 o; o.x = sp[0]; o.y = sp[64]; o.z = sp[128]; o.w = sp[192];
        *(GAS u32x4*)(WT + (drow0 + n) * (size_t)Kd + k0 + 16 * c) = o; }
    LDS_WAIT(); asm volatile("" ::: "memory");
}
template <int PART>
__device__ __forceinline__ void expert_convert(Frame& F) {
    LAS unsigned* scr = (LAS unsigned*)(F.lds + F.wave * 16384);
    const int gw = F.vcu * 8 + F.wave, NGW = F.G * 8;
    unsigned char* W13Q = F.wsh + WS_W13; unsigned char* W2Q = F.wsh + WS_W2;
    if constexpr (PART == 0) {
        constexpr int I_E1 = 4 * 8;
        for (int r = gw; r < NEXP * 2 * I_E1; r += NGW) {
            const int e = r / (2 * I_E1); int q = r % (2 * I_E1);
            const int s = q >= I_E1; q -= s * I_E1; const int kb = q >> 3, nb = q & 7, f0 = nb * 64;
            const float* W = (s ? F.in[19] : F.in[18]) + (size_t)e * DM * EH;
            const size_t drow = (size_t)e * 1024 + 256 * (f0 >> 7) + 128 * s + (f0 & 127);
            cv_item_f8<4>(W, EH, F.in[13], W13_SCALE, kb * 256, f0, W13Q, DM, drow, scr, F.lane); }
    } else {
        constexpr int I_E2 = 4 * 16, QITEMS = NEXP * I_E2 / 4;
        if ((F.wave & 1) != (PART & 1)) return;
        for (int r0 = gw >> 1; r0 < QITEMS; r0 += NGW / 2) {
            const int r = r0 + (PART - 1) * QITEMS;
            const int e = r / I_E2, q = r % I_E2, kb = q >> 4, nb = q & 15;
            const float* W = F.in[20] + (size_t)e * EH * DM;
            cv_item_f8<2>(W, DM, nullptr, W2_SCALE, kb * 128, nb * 64, W2Q, EH, (size_t)e * 1024 + nb * 64, scr, F.lane); }
    }
}

struct ATask { const bf16* qp; const bf16* kp; const bf16* vp; bf16* op; float* lp; long qstride, kvstride, ostride; int kfirst, jmin, jmax, lstride; };
__device__ __forceinline__ ATask p2_make_task(const Frame& F, int t, int b, int ci, int h) {
    const bf16* Z = (const bf16*)(F.wsh + WS_Z); const bf16* KVM = (const bf16*)(F.ws + WS_KVM); bf16* MIX = (bf16*)(F.wsh + WS_MIX);
    bf16* PO = (bf16*)(F.wsh + WS_PO); float* LP = (float*)(F.ws + WS_LP);
    ATask a; const long rowbase = (long)b * SEQ; const int s0 = ci * 512;
    if (t == 0) { const int mh = h & 3, sb = 8 * (h >> 2) + F.wave; const long tok0 = rowbase + s0 + 32 * sb;
        a.qp = Z + ((size_t)(28 + mh) * T + tok0) * 64; a.qstride = 64; a.kp = KVM + (size_t)b * NMEM * 512 + 64 * mh; a.vp = a.kp + 256; a.kvstride = 512; a.kfirst = 0; a.jmin = 0; a.jmax = 7;
        a.op = MIX + tok0 * DM + 768 + 64 * mh; a.ostride = DM; a.lp = nullptr; a.lstride = 0; }
    else { const int pat = (t - 1) >> 1, half = (t - 1) & 1, dil = pat == 0 ? 1 : (pat == 1 ? 4 : 16), tk = F.wave + 8 * half;
        int res, q0sub;
        if (pat == 0) { res = 0; q0sub = s0 + 32 * tk; } else if (pat == 1) { res = tk >> 2; q0sub = s0 / 4 + 32 * (tk & 3); } else { res = tk; q0sub = s0 / 16; }
        const long qtok = rowbase + (long)dil * q0sub + res;
        a.qp = Z + ((size_t)h * T + qtok) * 64; a.qstride = (long)dil * 64; a.kp = Z + ((size_t)(8 + h) * T + rowbase + res) * 64; a.vp = a.kp + (size_t)8 * T * 64; a.kvstride = (long)dil * 64;
        a.kfirst = q0sub - 128; a.jmin = q0sub >= 128 ? 0 : (128 - q0sub) / 32; a.jmax = 4;
        a.op = PO + ((size_t)pat * T + qtok) * 512 + 64 * h; a.ostride = (long)dil * 512; a.lp = LP + ((size_t)pat * T + qtok) * 8 + h; a.lstride = dil * 8; }
    return a;
}
__device__ __forceinline__ void kload4(bf16x8 (&k)[4], const bf16* p) {
    asm volatile("global_load_dwordx4 %0, %4, off\n\tglobal_load_dwordx4 %1, %4, off offset:32\n\tglobal_load_dwordx4 %2, %4, off offset:64\n\tglobal_load_dwordx4 %3, %4, off offset:96"
                 : "=&v"(k[0]), "=&v"(k[1]), "=&v"(k[2]), "=&v"(k[3]) : "v"(p) : "memory");
}
__device__ __forceinline__ void glds16(const void* gsrc, unsigned lds_dst) { unsigned keep;
    asm volatile("s_mov_b32 %0, m0\n\ts_mov_b32 m0, %2\n\ts_nop 0\n\tglobal_load_lds_dwordx4 %1, off\n\ts_mov_b32 m0, %0" : "=&s"(keep) : "v"(gsrc), "s"(lds_dst) : "memory"); }
__device__ __forceinline__ void p2_attention(Frame& F) {
    const bf16* Z = (const bf16*)(F.wsh + WS_Z); bf16* MIX = (bf16*)(F.wsh + WS_MIX);
    const bf16* PO = (const bf16*)(F.wsh + WS_PO); const float* LP = (const float*)(F.ws + WS_LP);
    LAS unsigned char* wl = F.lds + F.wave * 16384; LAS float* wsf = (LAS float*)(F.lds + WSCR_OFF + F.wave * 256);
    const unsigned wl0 = (unsigned)(uintptr_t)wl;
    const int lane = F.lane, r32 = lane & 31, hi = lane >> 5;
    const int vlane = ((lane >> 4) & 1) * 32 + (lane & 3) * 8 + (4 * hi + ((lane & 15) >> 2)) * 64;
    for (int cid = F.vcu; cid < 256; cid += F.G) {
        const int b = cid >> 6, h = 4 * ((cid >> 5) & 1) + (cid & 3), ci = (cid >> 2) & 7;
        const int s0 = ci * 512; const long rowbase = (long)b * SEQ;
        { LAS unsigned char* pl = F.lds; const int g = h >> 1;
          { const bf16* up = Z + ((size_t)(24 + (h >> 1)) * T + rowbase + s0 + F.tid) * 64 + 32 * (h & 1); u32x4 v[4];
#pragma unroll
            for (int q = 0; q < 4; ++q) v[q] = *(const u32x4*)(up + 8 * q);
            u32x4 hv[4];
            if (F.tid < 15) {
#pragma unroll
                for (int q = 0; q < 4; ++q) hv[q] = (s0 > 0) ? *(const u32x4*)(up - 15L * 64 + 8 * q) : (u32x4){0u, 0u, 0u, 0u}; }
#pragma unroll
            for (int q = 0; q < 4; ++q) *(LAS u32x4*)(pl + (F.tid + 15) * 80 + 16 * q) = v[q];
            if (F.tid < 15) {
#pragma unroll
                for (int q = 0; q < 4; ++q) *(LAS u32x4*)(pl + F.tid * 80 + 16 * q) = hv[q]; } }
          LDS_WAIT(); __syncthreads();
          const int s = s0 + F.tid, w = 2 << g, cnt = (s + 1 < w) ? s + 1 : w;
          float a[32];
#pragma unroll
          for (int c = 0; c < 32; ++c) a[c] = 0.f;
          u32x4 us[4];
          const LAS unsigned char* pr = pl + (F.tid + 15) * 80;
#pragma unroll
          for (int q = 0; q < 4; ++q) us[q] = *(const LAS u32x4*)(pr + 16 * q);
#pragma unroll 2
          for (int r = 0; r < w; ++r) {
#pragma unroll
              for (int q = 0; q < 4; ++q) { const u32x4 v = *(const LAS u32x4*)(pr - r * 80 + 16 * q);
                  a[8 * q + 0] += bflo(v.x); a[8 * q + 1] += bfhi(v.x); a[8 * q + 2] += bflo(v.y); a[8 * q + 3] += bfhi(v.y);
                  a[8 * q + 4] += bflo(v.z); a[8 * q + 5] += bfhi(v.z); a[8 * q + 6] += bflo(v.w); a[8 * q + 7] += bfhi(v.w); } }
          const float inv = 1.0f / (float)cnt;
          bf16* op = MIX + (rowbase + s) * DM + 512 + 32 * h;
#pragma unroll
          for (int q = 0; q < 4; ++q) { u32x4 w4;
              w4.x = pk2(a[8 * q + 0] * inv - bflo(us[q].x), a[8 * q + 1] * inv - bfhi(us[q].x)); w4.y = pk2(a[8 * q + 2] * inv - bflo(us[q].y), a[8 * q + 3] * inv - bfhi(us[q].y));
              w4.z = pk2(a[8 * q + 4] * inv - bflo(us[q].z), a[8 * q + 5] * inv - bfhi(us[q].z)); w4.w = pk2(a[8 * q + 6] * inv - bflo(us[q].w), a[8 * q + 7] * inv - bfhi(us[q].w));
              *(u32x4*)(op + 8 * q) = w4; }
          LDS_WAIT(); __syncthreads(); }
        VM_WAIT();
        ATask ia = p2_make_task(F, 0, b, ci, h), ca = ia; int it = 0, ij = ia.jmin, ct = 0, cj = ia.jmin;
        bf16x8 kA[4], kB[4], kC[4], qr[4];
        const LAS unsigned char* qb = wl + 12288;
#define P2_QDMA(A) do { const bf16* qs_ = (A).qp + (long)(lane >> 3) * (A).qstride + (lane & 7) * 8; \
            _Pragma("unroll") for (int i_ = 0; i_ < 4; ++i_) glds16(qs_ + (long)(8 * i_) * (A).qstride, (unsigned)__builtin_amdgcn_readfirstlane(wl0 + 12288 + i_ * 1024)); } while (0)
#define P2_QREAD() do { _Pragma("unroll") for (int d0 = 0; d0 < 4; ++d0) qr[d0] = *(const LAS bf16x8*)(qb + r32 * 128 + d0 * 32 + hi * 16); LDS_WAIT(); asm volatile("" ::: "memory"); } while (0)
        P2_QDMA(ca);
        asm volatile("s_waitcnt vmcnt(0)" ::: "memory");
        P2_QREAD();
        { const ATask na = p2_make_task(F, 1, b, ci, h); P2_QDMA(na); }
#define P2_ISSUE(KS, slot) do { const long tb_ = (long)(ia.kfirst + 32 * ij) * ia.kvstride; \
            kload4(KS, ia.kp + tb_ + (long)r32 * ia.kvstride + 8 * hi); \
            const bf16* vt_ = ia.vp + tb_ + (long)(lane >> 2) * ia.kvstride + (lane & 3) * 8; \
            _Pragma("unroll") for (int i_ = 0; i_ < 4; ++i_) glds16(vt_ + (long)(i_ & 1) * 16 * ia.kvstride + (i_ >> 1) * 32, (unsigned)__builtin_amdgcn_readfirstlane(wl0 + (slot) * 4096 + i_ * 1024)); \
            if (ij < ia.jmax) ++ij; else if (it < 6) { ++it; ia = p2_make_task(F, it, b, ci, h); ij = ia.jmin; } } while (0)
        P2_ISSUE(kA, 0); P2_ISSUE(kB, 1);
        f32x16 o[2]; float lacc = 0.f;
#pragma unroll
        for (int r = 0; r < 16; ++r) { o[0][r] = 0.f; o[1][r] = 0.f; }
        bool done = false;
#define P2_STEP(KC, KI, slotc, sloti) do { \
            P2_ISSUE(KI, sloti); \
            asm volatile("s_waitcnt vmcnt(16) ; KSET %0 %1 %2 %3" : "+v"(KC[0]), "+v"(KC[1]), "+v"(KC[2]), "+v"(KC[3]) :: "memory"); \
            __builtin_amdgcn_sched_barrier(0); \
              \
            const LAS unsigned char* vb = wl + (slotc) * 4096; \
            bf16x8 vf[2][2]; \
            _Pragma("unroll") for (int d0 = 0; d0 < 2; ++d0) { \
                _Pragma("unroll") for (int ks = 0; ks < 2; ++ks) { \
                    const LAS unsigned char* vp_ = vb + (d0 * 2 + ks) * 1024 + vlane; \
                    const s16x4 lo = __builtin_bit_cast(s16x4, __builtin_amdgcn_ds_read_tr16_b64_v4i16((LAS s16x4*)vp_)); \
                    const s16x4 hh = __builtin_bit_cast(s16x4, __builtin_amdgcn_ds_read_tr16_b64_v4i16((LAS s16x4*)(vp_ + 512))); \
                    vf[d0][ks] = (bf16x8){lo[0], lo[1], lo[2], lo[3], hh[0], hh[1], hh[2], hh[3]}; } } \
            __builtin_amdgcn_sched_barrier(0); \
            f32x16 p; \
            _Pragma("unroll") for (int r = 0; r < 16; ++r) p[r] = 0.f; \
            _Pragma("unroll") for (int d0 = 0; d0 < 4; ++d0) p = __builtin_amdgcn_mfma_f32_32x32x16_bf16(KC[d0], qr[d0], p, 0, 0, 0); \
            const int mm = (ct > 0) ? (cj == 0 ? 1 : (cj == 4 ? 2 : 0)) : 0; \
            _Pragma("unroll") for (int r = 0; r < 16; ++r) p[r] = __builtin_amdgcn_exp2f(p[r]); \
            if (mm != 0) { const int klo = (mm == 1) ? r32 : -1, khi = (mm == 2) ? r32 : 64; \
                _Pragma("unroll") for (int r = 0; r < 16; ++r) { const int kj = crow(r, hi); p[r] = (kj >= klo && kj <= khi) ? p[r] : 0.f; } } \
            lacc += (((p[0] + p[1]) + (p[2] + p[3])) + ((p[4] + p[5]) + (p[6] + p[7]))) + (((p[8] + p[9]) + (p[10] + p[11])) + ((p[12] + p[13]) + (p[14] + p[15]))); \
            u32x4 pw0, pw1; \
            pw0.x = pk2(p[0], p[1]); pw0.y = pk2(p[2], p[3]); pw0.z = pk2(p[4], p[5]); pw0.w = pk2(p[6], p[7]); \
            pw1.x = pk2(p[8], p[9]); pw1.y = pk2(p[10], p[11]); pw1.z = pk2(p[12], p[13]); pw1.w = pk2(p[14], p[15]); \
            const bf16x8 pa0 = __builtin_bit_cast(bf16x8, pw0), pa1 = __builtin_bit_cast(bf16x8, pw1); \
            _Pragma("unroll") for (int d0 = 0; d0 < 2; ++d0) { \
                _Pragma("unroll") for (int ks = 0; ks < 2; ++ks) o[d0] = __builtin_amdgcn_mfma_f32_32x32x16_bf16(ks ? pa1 : pa0, vf[d0][ks], o[d0], 0, 0, 0); } \
            asm volatile("" ::: "memory"); \
            if (cj == ca.jmax) { \
                LAS bf16* stg = (LAS bf16*)(wl + (slotc) * 4096);            \
                const float l = lacc + __shfl_xor(lacc, 32); \
                if (hi == 0) wsf[r32] = 1.0f / l; \
                LDS_WAIT(); asm volatile("" ::: "memory"); \
                _Pragma("unroll") for (int r = 0; r < 16; ++r) { const int qq = crow(r, hi); const float iv = wsf[qq]; \
                    _Pragma("unroll") for (int d0 = 0; d0 < 2; ++d0) stg[qq * 64 + 32 * d0 + r32] = (bf16)f2bf(o[d0][r] * iv); } \
                LDS_WAIT(); asm volatile("" ::: "memory"); \
                u32x4 ov[4]; \
                _Pragma("unroll") for (int i_ = 0; i_ < 4; ++i_) ov[i_] = *(const LAS u32x4*)(stg + (i_ * 8 + (lane >> 3)) * 64 + (lane & 7) * 8); \
                LDS_WAIT(); asm volatile("" ::: "memory"); \
                if (ct < 6) { asm volatile("s_waitcnt vmcnt(8)" ::: "memory");     \
                    P2_QREAD(); \
                    if (ct < 5) { const ATask na = p2_make_task(F, ct + 2, b, ci, h); P2_QDMA(na); } } \
                if (hi == 0 && ca.lp) ca.lp[(long)r32 * ca.lstride] = l; \
                _Pragma("unroll") for (int i_ = 0; i_ < 4; ++i_) *(u32x4*)(ca.op + (long)(i_ * 8 + (lane >> 3)) * ca.ostride + (lane & 7) * 8) = ov[i_]; \
                if (ct == 6) done = true; \
                else { ++ct; ca = p2_make_task(F, ct, b, ci, h); cj = ca.jmin; \
                    _Pragma("unroll") for (int r = 0; r < 16; ++r) { o[0][r] = 0.f; o[1][r] = 0.f; } lacc = 0.f; } \
            } else ++cj; } while (0)
        for (;;) {
            P2_STEP(kA, kC, 0, 2); if (done) break;
            P2_STEP(kB, kA, 1, 0); if (done) break;
            P2_STEP(kC, kB, 2, 1); if (done) break;
        }
#undef P2_STEP
#undef P2_ISSUE
#undef P2_QDMA
#undef P2_QREAD
        asm volatile("s_waitcnt vmcnt(0) ; KSETS %0 %1 %2" : "+v"(kA[0]), "+v"(kB[0]), "+v"(kC[0]) :: "memory");
        asm volatile("" : "+v"(kA[1]), "+v"(kA[2]), "+v"(kA[3]), "+v"(kB[1]), "+v"(kB[2]), "+v"(kB[3]), "+v"(kC[1]), "+v"(kC[2]), "+v"(kC[3]));
        __syncthreads();
        { const long row = rowbase + s0 + F.tid;
          const float l0 = LP[((size_t)0 * T + row) * 8 + h], l1 = LP[((size_t)1 * T + row) * 8 + h], l2 = LP[((size_t)2 * T + row) * 8 + h];
          const float il = 1.0f / (l0 + l1 + l2), w0 = l0 * il, w1 = l1 * il, w2 = l2 * il;
          const bf16* p0 = PO + ((size_t)0 * T + row) * 512 + 64 * h; const bf16* p1 = PO + ((size_t)1 * T + row) * 512 + 64 * h; const bf16* p2 = PO + ((size_t)2 * T + row) * 512 + 64 * h;
          bf16* op = MIX + row * DM + 64 * h;
#pragma unroll
          for (int c = 0; c < 8; ++c) { const u32x4 a = *(const u32x4*)(p0 + 8 * c), bb = *(const u32x4*)(p1 + 8 * c), cc = *(const u32x4*)(p2 + 8 * c); u32x4 w;
              w.x = pk2(w0 * bflo(a.x) + w1 * bflo(bb.x) + w2 * bflo(cc.x), w0 * bfhi(a.x) + w1 * bfhi(bb.x) + w2 * bfhi(cc.x));
              w.y = pk2(w0 * bflo(a.y) + w1 * bflo(bb.y) + w2 * bflo(cc.y), w0 * bfhi(a.y) + w1 * bfhi(bb.y) + w2 * bfhi(cc.y));
              w.z = pk2(w0 * bflo(a.z) + w1 * bflo(bb.z) + w2 * bflo(cc.z), w0 * bfhi(a.z) + w1 * bfhi(bb.z) + w2 * bfhi(cc.z));
              w.w = pk2(w0 * bflo(a.w) + w1 * bflo(bb.w) + w2 * bflo(cc.w), w0 * bfhi(a.w) + w1 * bfhi(bb.w) + w2 * bfhi(cc.w));
              *(u32x4*)(op + 8 * c) = w; } }
        VM_WAIT(); __syncthreads();
    }
}

__device__ __forceinline__ void p4_router(Frame& F) {
    const bf16* XG = (const bf16*)(F.wsh + WS_XG); const bf16* RT = (const bf16*)(F.ws + WS_RT); const float* SSQ = (const float*)(F.ws + WS_SSQ);
    unsigned* TOKPOS = (unsigned*)(F.ws + WS_TOKPOS); unsigned* ROWTOK = (unsigned*)(F.ws + WS_ROWTOK); float* ROWGATE = (float*)(F.ws + WS_ROWGATE);
    unsigned* CNT = (unsigned*)(F.ws + WS_CTL) + CW_CNT; float* ROWRSTD = (float*)(F.ws + WS_ROWRSTD);
    const float* bg = F.in[15]; const float* br = F.in[17]; unsigned char* X1Q = F.wsh + WS_X1Q;
    LAS float* PL = (LAS float*)F.lds;
    LAS unsigned* hist = (LAS unsigned*)(F.lds + 100352); LAS unsigned* hbase = hist + 64;
    const int lane = F.lane, r32 = lane & 31, hi = lane >> 5, tb = F.wave >> 2, kq = F.wave & 3;
    if (F.vcu == 0 && F.tid < 256) ((unsigned*)(X1Q + (size_t)T * DM))[F.tid] = 0u;
    for (int tg = F.vcu; tg < T / 64; tg += F.G) {
        const int tok = tg * 64 + tb * 32 + r32;
        f32x16 acc[3];
#pragma unroll
        for (int nb = 0; nb < 3; ++nb)
#pragma unroll
            for (int r = 0; r < 16; ++r) acc[nb][r] = 0.f;
        const bf16* ap = XG + (size_t)tok * DM + 256 * kq + 8 * hi; const bf16* bp = RT + (size_t)r32 * DM + 256 * kq + 8 * hi;
#pragma unroll 4
        for (int s = 0; s < 16; ++s) { const bf16x8 a = *(const bf16x8*)(ap + 16 * s);
            { const u32x4 aw = __builtin_bit_cast(u32x4, a); u32x2 q8; q8.x = pk4f8(bflo(aw.x), bfhi(aw.x), bflo(aw.y), bfhi(aw.y)); q8.y = pk4f8(bflo(aw.z), bfhi(aw.z), bflo(aw.w), bfhi(aw.w));
              *(u32x2*)(X1Q + (size_t)tok * DM + 256 * kq + 16 * s + 8 * hi) = q8; }
#pragma unroll
            for (int nb = 0; nb < 3; ++nb) { const bf16x8 bb = *(const bf16x8*)(bp + (size_t)nb * 32 * DM + 16 * s); acc[nb] = __builtin_amdgcn_mfma_f32_32x32x16_bf16(bb, a, acc[nb], 0, 0, 0); } }
        LAS float* pw = PL + (size_t)(F.wave * 32 + r32) * 97;
#pragma unroll
        for (int nb = 0; nb < 3; ++nb)
#pragma unroll
            for (int r = 0; r < 16; ++r) pw[32 * nb + crow(r, hi)] = acc[nb][r];
        if (F.tid < 64) hist[F.tid] = 0u;
        LDS_WAIT(); __syncthreads();
        int e1 = 0, e2 = 0; unsigned k1 = 0, k2 = 0; float g1 = 0.f, g2 = 0.f, rstdv = 0.f;
        if (F.tid < 64) {
            const int t2 = F.tid >> 5, rr = F.tid & 31, tk = tg * 64 + F.tid;
            const LAS float* p0 = PL + (size_t)((t2 * 4) * 32 + rr) * 97;
#define LOGIT(n) (p0[(n)] + p0[32 * 97 + (n)] + p0[64 * 97 + (n)] + p0[96 * 97 + (n)])
            float ss = 0.f;
#pragma unroll
            for (int i = 0; i < 4; ++i) { const f32x4 v = *(const f32x4*)(SSQ + (size_t)tk * 16 + 4 * i); ss += (v[0] + v[1]) + (v[2] + v[3]); }
            const float rstd = 1.0f / sqrtf(ss * (1.f / DM) + EPS);
            float lg[8]; int g = 0; float gm = -3.0e38f;
#pragma unroll
            for (int j = 0; j < 8; ++j) { lg[j] = rstd * LOGIT(j) + bg[j]; if (lg[j] > gm) { gm = lg[j]; g = j; } }
            float den = 0.f;
#pragma unroll
            for (int j = 0; j < 8; ++j) den += __expf(lg[j] - gm);
            const float pg = 1.0f / den;
            float le[8]; int i1 = 0; float v1 = -3.0e38f;
#pragma unroll
            for (int j = 0; j < 8; ++j) { le[j] = rstd * LOGIT(8 + 8 * g + j) + br[8 * g + j]; if (le[j] > v1) { v1 = le[j]; i1 = j; } }
            int i2 = 0; float v2 = -3.0e38f;
#pragma unroll
            for (int j = 0; j < 8; ++j) { if (j != i1 && le[j] > v2) { v2 = le[j]; i2 = j; } }
#undef LOGIT
            const float p1 = 1.0f / (1.0f + __expf(v2 - v1)), p2 = 1.0f - p1;
            rstdv = rstd;
            e1 = 8 * g + i1; e2 = 8 * g + i2; g1 = pg * p1; g2 = pg * p2;
            k1 = __hip_atomic_fetch_add(&hist[e1], 1u, __ATOMIC_RELAXED, __HIP_MEMORY_SCOPE_WORKGROUP); k2 = __hip_atomic_fetch_add(&hist[e2], 1u, __ATOMIC_RELAXED, __HIP_MEMORY_SCOPE_WORKGROUP);
        }
        LDS_WAIT(); __syncthreads();
        if (F.tid < 64) { const unsigned n = hist[F.tid]; hbase[F.tid] = n ? atomicAdd(&CNT[F.tid * CNT_STRIDE], n) : 0u; }
        LDS_WAIT(); __syncthreads();
        if (F.tid < 64) { const int tk = tg * 64 + F.tid;
            const unsigned sl1 = (unsigned)e1 * CAP + hbase[e1] + k1, sl2 = (unsigned)e2 * CAP + hbase[e2] + k2;
            ROWTOK[sl1] = (unsigned)tk; ROWGATE[sl1] = g1; ROWRSTD[sl1] = rstdv; ROWTOK[sl2] = (unsigned)tk; ROWGATE[sl2] = g2; ROWRSTD[sl2] = rstdv;
            TOKPOS[2 * tk] = sl1; TOKPOS[2 * tk + 1] = sl2;
        }
        __syncthreads();
    }
}

__device__ __forceinline__ void p7_combine(Frame& F, const LAS int* tab) {
    const unsigned* TOKPOS = (const unsigned*)(F.ws + WS_TOKPOS); const bf16* YB = (const bf16*)(F.wsh + WS_YB);
    const int gw = F.vcu * 8 + F.wave, NGW = F.G * 8;
    for (int m = gw; m < T; m += NGW) {
        const unsigned s1 = TOKPOS[2 * m], s2 = TOKPOS[2 * m + 1];
        const size_t h1 = (size_t)tab[259 + (s1 >> 15)] + (s1 & 32767u), h2 = (size_t)tab[259 + (s2 >> 15)] + (s2 & 32767u);
        const GAS u32x2* x1 = (const GAS u32x2*)((const bf16*)(F.wsh + WS_XG) + (size_t)m * DM) + F.lane; GAS f32x4* od = (GAS f32x4*)(F.out + (size_t)m * DM) + F.lane;
        const GAS u32x2* y1 = (const GAS u32x2*)(YB + h1 * DM) + F.lane; const GAS u32x2* y2 = (const GAS u32x2*)(YB + h2 * DM) + F.lane;
#pragma unroll
        for (int j = 0; j < 4; ++j) { const u32x2 xx = __builtin_nontemporal_load(&x1[64 * j]), a = __builtin_nontemporal_load(&y1[64 * j]), b = __builtin_nontemporal_load(&y2[64 * j]); f32x4 v;
            v[0] = bflo(xx.x) + (bflo(a.x) + bflo(b.x)); v[1] = bfhi(xx.x) + (bfhi(a.x) + bfhi(b.x)); v[2] = bflo(xx.y) + (bflo(a.y) + bflo(b.y)); v[3] = bfhi(xx.y) + (bfhi(a.y) + bfhi(b.y)); __builtin_nontemporal_store(v, &od[64 * j]); }
    }
}

__global__ void __launch_bounds__(512, 2) fwd_kernel(Args args) {
    extern __shared__ __attribute__((aligned(16))) unsigned char lds[];
    Frame F;
    F.lds = (LAS unsigned char*)lds; F.tid = threadIdx.x; F.lane = F.tid & 63; F.wave = __builtin_amdgcn_readfirstlane(F.tid >> 6);
    F.G = gridDim.x; { const int bx = blockIdx.x; F.vcu = (F.G % 8 == 0) ? (bx % 8) * (F.G / 8) + bx / 8 : bx; }
#pragma unroll
    for (int i = 0; i < 21; ++i) F.in[i] = args.in[i];
    F.out = args.out; F.ws = args.ws; F.wsh = args.wsh;
    volatile LAS unsigned* MISC = (volatile LAS unsigned*)(F.lds + MISC_OFF);
    for (int u = F.tid; u < (LDS_BYTES - LDSCTL_OFF) / 4; u += 512) ((LAS unsigned*)(F.lds + LDSCTL_OFF))[u] = 0u;
    __syncthreads();
    unsigned* ctl = (unsigned*)(F.ws + WS_CTL);
    XcdBarrier bar = xcd_barrier_post(ctl + CW_BAR, MISC + 8);
    const int lo = args.ph_lo, hi = args.ph_hi;
#define IN(k) (lo <= (k) && (k) < hi)
#define SEAM(k) do { if (IN(k) && IN((k) + 1)) xcd_barrier(bar); } while (0)
    LAS int* tab = (LAS int*)(F.lds + TAB_OFF);

    if (IN(0)) { p0_prologue(F); }
    { const XbTicket t01 = xcd_barrier_arrive(bar); expert_convert<1>(F); LDS_WAIT(); xcd_barrier_wait(bar, t01); }
    if (IN(1)) {
        pg8::Gemm g{(const bf16*)(F.wsh + WS_XB), (const bf16*)(F.ws + WS_WIN), DM}; pg8::StaticOrder S; S.init(T, INW, F.G, (int)blockIdx.x);
        LAS float* gz = (LAS float*)(F.lds + GZ_OFF);
        if (F.tid < 192) gz[F.tid] = F.tid < 64 ? F.in[4][F.tid] * C2 : (F.tid < 128 ? F.in[5][F.tid - 64] : F.in[10][F.tid - 128] * C2);
        LDS_WAIT(); __syncthreads();
        pg8::EpiZ E{(bf16*)(F.wsh + WS_Z), (const float*)(F.ws + WS_RS), gz};
        pg8::gemm_phase<pg8::EpiZ, pg8::StaticOrder, false, false>(F.lds, g, S, E);
    }
    { const XbTicket t12 = xcd_barrier_arrive(bar); expert_convert<2>(F); LDS_WAIT(); xcd_barrier_wait(bar, t12); }
    if (IN(2)) { p2_attention(F); }
    { const XbTicket t23 = xcd_barrier_arrive(bar); expert_convert<3>(F); LDS_WAIT(); xcd_barrier_wait(bar, t23); }
    if (IN(3)) {
        pg8::Gemm g{(const bf16*)(F.wsh + WS_MIX), (const bf16*)(F.ws + WS_WOUT), DM}; pg8::StaticOrder S; S.init(T, DM, F.G, (int)blockIdx.x);
        pg8::EpiX1 E{(const bf16*)(F.wsh + WS_XB), (bf16*)(F.wsh + WS_XG), (float*)(F.ws + WS_SSQ)};
        pg8::gemm_phase<pg8::EpiX1, pg8::StaticOrder, false, false>(F.lds, g, S, E);
    }
    const XbTicket t34 = xcd_barrier_arrive(bar);
    expert_convert<0>(F);
    LDS_WAIT();
    xcd_barrier_wait(bar, t34);
    p4_router(F);
    const XbTicket t45 = xcd_barrier_arrive(bar);
    expert_convert<4>(F);
    LDS_WAIT();
    xcd_barrier_wait(bar, t45);
    if (IN(5) || IN(6) || IN(7)) {
        if (F.tid < 64) { const int c = (int)__hip_atomic_load(ctl + CW_CNT + F.tid * CNT_STRIDE, RLX_AGENT); const int ntl = (c + 255) >> 8;
            const int lt = (ntl > 0 && c - (ntl - 1) * 256 <= 128) ? 1 : 0; int i0 = ntl, i1 = ntl - lt, i2 = lt, i3 = c;
#pragma unroll
            for (int o = 1; o < 64; o <<= 1) { const int v0 = __shfl_up(i0, o), v1 = __shfl_up(i1, o), v2 = __shfl_up(i2, o), v3 = __shfl_up(i3, o); if (F.lane >= o) { i0 += v0; i1 += v1; i2 += v2; i3 += v3; } }
            tab[F.tid] = c; tab[64 + F.tid + 1] = i0; tab[129 + F.tid + 1] = i1; tab[194 + F.tid + 1] = i2; tab[259 + F.tid + 1] = i3; if (F.tid == 0) { tab[64] = 0; tab[129] = 0; tab[194] = 0; tab[259] = 0; } }
        LDS_WAIT(); __syncthreads();
    }
    if (IN(5)) {
        pg8::Gemm g{(const bf16*)(F.wsh + WS_X1Q), (const bf16*)(F.wsh + WS_W13), DM / 2};
        pg8::GroupOrder S{tab, (const unsigned*)(F.ws + WS_ROWTOK), F.G, (int)blockIdx.x};
        pg8::EpiH E{F.wsh + WS_HMID, (const float*)(F.ws + WS_ROWRSTD)};
        pg8::gemm_phase<pg8::EpiH, pg8::GroupOrder, true, true>(F.lds, g, S, E);
    }
    SEAM(5);
    if (IN(6)) {
        pg8::Gemm g{(const bf16*)(F.wsh + WS_HMID), (const bf16*)(F.wsh + WS_W2), EH / 2};
        pg8::GroupOrder S{tab, (const unsigned*)(F.ws + WS_ROWTOK), F.G, (int)blockIdx.x};
        pg8::EpiY E{(bf16*)(F.wsh + WS_YB), (const float*)(F.ws + WS_ROWGATE), tab};
        pg8::gemm_phase<pg8::EpiY, pg8::GroupOrder, false, true>(F.lds, g, S, E);
    }
    SEAM(6);
    if (IN(7)) { p7_combine(F, tab); }
#undef IN
#undef SEAM
}

extern "C" void kernel_launch(void* const* d_in, const int* in_sizes, int n_in, void* d_out, int out_size, void* d_ws, size_t ws_size, hipStream_t stream) {
    static int grid = 0;
    if (grid == 0) {
        if (n_in != 21 || out_size != T * DM || ws_size < WS_END) { fprintf(stderr, "kernel_launch: unexpected shapes (n_in %d out %d ws %zu)\n", n_in, out_size, ws_size); grid = -1; return; }
        int dev = 0, cus = 0, per_cu = 0;
        if (hipGetDevice(&dev) != hipSuccess || hipDeviceGetAttribute(&cus, hipDeviceAttributeMultiprocessorCount, dev) != hipSuccess) { grid = -1; return; }
        if (hipFuncSetAttribute((const void*)fwd_kernel, hipFuncAttributeMaxDynamicSharedMemorySize, LDS_BYTES) != hipSuccess) { fprintf(stderr, "kernel_launch: hipFuncSetAttribute failed\n"); grid = -1; return; }
        if (hipOccupancyMaxActiveBlocksPerMultiprocessor(&per_cu, (const void*)fwd_kernel, 512, LDS_BYTES) != hipSuccess || per_cu < 1) { fprintf(stderr, "kernel_launch: occupancy query says %d\n", per_cu); }
        (void)hipGetLastError();
        grid = cus;
    }
    if (grid < 0) return;
    if (hipMemsetAsync((char*)d_ws + WS_CTL, 0, CTL_ZERO_BYTES, stream) != hipSuccess) return;
    Args a{};
    for (int i = 0; i < 21; ++i) a.in[i] = (const float*)d_in[i];
    a.out = (float*)d_out; a.ws = (unsigned char*)d_ws; a.wsh = (unsigned char*)d_ws + (((ws_size >> 20) << 20) - WS_END); a.ph_lo = 0; a.ph_hi = 8;
    hipLaunchKernelGGL(fwd_kernel, dim3(grid), dim3(512), LDS_BYTES, stream, a);
}
```

```cpp
#include <hip/hip_runtime.h>
#include <cstdio>
#include <cstdint>

#define LAS __attribute__((address_space(3)))
#define GAS __attribute__((address_space(1)))
typedef unsigned short bf16;
typedef short bf16x8 __attribute__((ext_vector_type(8)));
typedef short s16x4 __attribute__((ext_vector_type(4)));
typedef float f32x4 __attribute__((ext_vector_type(4)));
typedef float f32x16 __attribute__((ext_vector_type(16)));
typedef float f32x2 __attribute__((ext_vector_type(2)));
typedef __bf16 bf16x2_t __attribute__((ext_vector_type(2)));
typedef unsigned u32x4 __attribute__((ext_vector_type(4)));
typedef unsigned u32x2 __attribute__((ext_vector_type(2)));
typedef GAS unsigned gu32;
typedef int v4i __attribute__((ext_vector_type(4)));
typedef int v8i __attribute__((ext_vector_type(8)));

constexpr int BATCH = 4, SEQ = 4096, DM = 1024, T = BATCH * SEQ;
constexpr int INW = 2048, NMEM = 256;
constexpr int NEXP = 64, EH = 512, CAP = 32768;
constexpr float EPS = 1e-6f;
constexpr float W13_SCALE = 64.f, W2_SCALE = 32.f, H_SCALE = 4.f, F8MAX = 448.f;
constexpr float C2 = 0.125f * 1.4426950408889634f;
constexpr int ZQ = 0, ZK = 512, ZV = 1024, ZU = 1536, ZQM = 1792;

constexpr size_t MiB = 1u << 20;
constexpr size_t WS_CTL = 0, CTL_ZERO_BYTES = 1 * MiB;
constexpr size_t WS_RS = 1 * MiB;
constexpr size_t WS_RSTD = 1 * MiB + 128 * 1024;
constexpr size_t WS_SSQ = 2 * MiB;
constexpr size_t WS_WIN = 4 * MiB;
constexpr size_t WS_WOUT = 8 * MiB;
constexpr size_t WS_RT = 10 * MiB;
constexpr size_t WS_KVM = 11 * MiB;
constexpr size_t WS_TOKPOS = 12 * MiB;
constexpr size_t WS_ROWTOK = 13 * MiB;
constexpr size_t WS_ROWGATE = 21 * MiB;
constexpr size_t WS_LP = 29 * MiB;
constexpr size_t WS_ROWRSTD = 50 * MiB;
constexpr size_t WS_XB = 480 * MiB;
constexpr size_t WS_XG = 480 * MiB;
constexpr size_t WS_Z = 416 * MiB;
constexpr size_t WS_W13 = 416 * MiB;
constexpr size_t WS_YB = 416 * MiB;
constexpr size_t WS_MIX = 384 * MiB;
constexpr size_t WS_W2 = 304 * MiB;
constexpr size_t WS_PO = 336 * MiB;
constexpr size_t WS_X1Q = 336 * MiB;
constexpr size_t WS_HMID = 356 * MiB;
constexpr size_t WS_END = 512 * MiB;
constexpr int CW_CNT = 16384, CNT_STRIDE = 64;
constexpr int CW_BAR = 4096;
constexpr int CW_Q13 = 12288;

constexpr int RING_BYTES = 131072;
constexpr int WSCR_OFF = RING_BYTES;
constexpr int TAB_OFF = WSCR_OFF + 2048;
constexpr int LDSCTL_OFF = TAB_OFF + 2048, MISC_OFF = LDSCTL_OFF;
constexpr int RSC_OFF = LDSCTL_OFF + 1024;
constexpr int LDS_BYTES = 147456;
constexpr int RTK_OFF = RSC_OFF + 3072;
constexpr int GZ_OFF = RTK_OFF + 2048;
static_assert(GZ_OFF + 768 <= LDS_BYTES, "LDS map");

#define RLX_AGENT __ATOMIC_RELAXED, __HIP_MEMORY_SCOPE_AGENT
#define LDS_WAIT() asm volatile("s_waitcnt lgkmcnt(0)" ::: "memory")
#define VM_WAIT() asm volatile("s_waitcnt vmcnt(0)" ::: "memory")
__device__ __forceinline__ unsigned f2bf(float f) { unsigned u = __builtin_bit_cast(unsigned, f); return (u + 0x7fffu + ((u >> 16) & 1u)) >> 16; }
__device__ __forceinline__ unsigned pk2(float lo, float hi) { f32x2 v = {lo, hi}; bf16x2_t b = __builtin_convertvector(v, bf16x2_t); return __builtin_bit_cast(unsigned, b); }
__device__ __forceinline__ unsigned pk4f8(float a, float b, float c, float d) {
    a = __builtin_amdgcn_fmed3f(a, -F8MAX, F8MAX); b = __builtin_amdgcn_fmed3f(b, -F8MAX, F8MAX); c = __builtin_amdgcn_fmed3f(c, -F8MAX, F8MAX); d = __builtin_amdgcn_fmed3f(d, -F8MAX, F8MAX);
    int w = 0; w = __builtin_amdgcn_cvt_pk_fp8_f32(a, b, w, false); w = __builtin_amdgcn_cvt_pk_fp8_f32(c, d, w, true); return (unsigned)w; }
__device__ __forceinline__ v8i cat8(bf16x8 a, bf16x8 b) { const v4i x = __builtin_bit_cast(v4i, a), y = __builtin_bit_cast(v4i, b); return __builtin_shufflevector(x, y, 0, 1, 2, 3, 4, 5, 6, 7); }
__device__ __forceinline__ float bf2f(unsigned short h) { return __builtin_bit_cast(float, (unsigned)h << 16); }
__device__ __forceinline__ float bflo(unsigned w) { return __builtin_bit_cast(float, w << 16); }
__device__ __forceinline__ float bfhi(unsigned w) { return __builtin_bit_cast(float, w & 0xffff0000u); }
__device__ __forceinline__ float wave_sum(float v) {
#pragma unroll
    for (int o = 1; o < 64; o <<= 1) v += __shfl_xor(v, o);
    return v;
}
__device__ __forceinline__ int crow(int r, int hi) { return (r & 3) + 8 * (r >> 2) + 4 * hi; }

namespace pg8 {
constexpr int BM = 256, BK = 64, HALF = 128, HTB = HALF * BK * 2, NXCD = 8, WGM = 8;
__host__ __device__ __forceinline__ int lds_byte(int r, int c) { const int st = (r >> 4) * 2 + (c >> 5), rr = r & 15, cc = c & 31, ob = rr * 64 + cc * 2; return st * 1024 + (ob ^ (((ob >> 9) & 1) << 5)); }
__host__ __device__ __forceinline__ void stage_rc(int b, int& R, int& C) { const int st = b / 1024, sb = b % 1024, swz = sb ^ (((sb >> 9) & 1) << 5); R = (st >> 1) * 16 + swz / 64; C = (st & 1) * 32 + (swz % 64) / 2; }
__host__ __device__ __forceinline__ int perm32(int rho) { const int n = rho >> 4, i = rho & 15; return 8 * (i >> 2) + 4 * n + (i & 3); }

struct Unit { int pm, pn, e, mt, cnt, light; };
struct Gemm { const bf16* A; const bf16* Bt; int K; };

struct StaticOrder {
    int nM, nN, nwg, G, c, sp;
    __device__ void init(int M, int N, int G_, int c_) { nM = M / BM; nN = N / BM; nwg = nM * nN; G = G_; c = c_; sp = 0; }
    __device__ bool next(int i, Unit& u) const {
        const long L = (long)i * G + c; if (L >= nwg) return false;
        int wgid = (int)L; { const int q = nwg / NXCD, r = nwg % NXCD, xcd = wgid % NXCD; int off = wgid / NXCD; if (sp) { const int i2 = off >> 4, k = off & 15; off = ((k >> 2) << 3) + 4 * i2 + (k & 3); }
            wgid = (xcd < r ? xcd * (q + 1) : r * (q + 1) + (xcd - r) * q) + off; }
        const int nig = WGM * nN, gid = wgid / nig, fm = gid * WGM, gsz = (nM - fm) < WGM ? (nM - fm) : WGM;
        u.pm = fm + ((wgid % nig) % gsz); u.pn = (wgid % nig) / gsz; u.e = 0; u.mt = 0; u.cnt = 0; u.light = 0; return true;
    }
    __device__ __forceinline__ int row(const Unit&, int) const { return 0; }
    __device__ __forceinline__ int row_lds(const Unit&, int, const LAS unsigned*) const { return 0; }
    __device__ __forceinline__ const unsigned* rtk_src(const Unit&) const { return nullptr; }
};
struct GroupOrder {
    const LAS int* tab;
    const unsigned* rowtok;
    int G, c;
    __device__ bool next(int i, Unit& u) const {
        const int NUH = tab[129 + 64] * 4, NUL = tab[194 + 64] * 4; long L = (long)i * G + c; if (L >= NUH + NUL) return false;
        const int lt = L >= NUH; const int NU = lt ? NUL : NUH; int wgid = (int)(lt ? L - NUH : L);
        { const int q = NU / NXCD, r = NU % NXCD, xcd = wgid % NXCD, off = wgid / NXCD; wgid = (xcd < r ? xcd * (q + 1) : r * (q + 1) + (xcd - r) * q) + off; }
        const int xt = wgid >> 2, pnl = wgid & 3, base = lt ? 194 : 129; int lo = 0;
#pragma unroll
        for (int st = 32; st >= 1; st >>= 1) { if (tab[base + lo + st] <= xt) lo += st; }
        const int ts = tab[64 + lo], ntl = tab[64 + lo + 1] - ts, mt = lt ? ntl - 1 : xt - tab[129 + lo];
        u.pm = ts + mt; u.pn = lo * 4 + pnl; u.e = lo; u.mt = mt; u.cnt = tab[lo]; u.light = lt; return true;
    }
    __device__ __forceinline__ int row(const Unit& u, int rl) const { const int idx = u.mt * 256 + rl; return idx < u.cnt ? (int)rowtok[(size_t)u.e * CAP + idx] : T; }
    __device__ __forceinline__ int row_lds(const Unit& u, int rl, const LAS unsigned* rt) const { const int idx = u.mt * 256 + rl; const int v = (int)rt[rl]; return idx < u.cnt ? v : T; }
    __device__ __forceinline__ const unsigned* rtk_src(const Unit& u) const { return rowtok + (size_t)u.e * CAP + u.mt * 256; }
};

template <class Epi, class Sched, bool GATHER, bool F8>
__device__ __forceinline__ void gemm_phase(LAS unsigned char* lds, const Gemm g, const Sched& S, const Epi& E) {
    const int tid = threadIdx.x, wid = __builtin_amdgcn_readfirstlane(tid >> 6), lane = tid & 63, wr = wid >> 2, wc = wid & 3, fr = lane & 15, fq = lane >> 4;
    const int K = g.K, nt = K / BK;
    unsigned voffA[2], voffB[2]; int RA[2], CA[2];
#pragma unroll
    for (int i = 0; i < 2; ++i) { int R, C; stage_rc(tid * 16 + i * 8192, R, C); const int Rb = Epi::PERM ? ((R & ~31) + perm32(R & 31)) : R;
        voffA[i] = (unsigned)(R * K + C) * 2u; voffB[i] = (unsigned)(Rb * K + C) * 2u; RA[i] = R; CA[i] = C; }
    const size_t kstep = (size_t)(BK * 2);
    const size_t hstep = (size_t)HALF * K * 2;
    const size_t tstep = 2 * hstep;
    const unsigned ldsw = (unsigned)wid * 1024u;
    const int aoff = lds_byte(wr * 64 + fr, fq * 8), boff = lds_byte(wc * 32 + fr, fq * 8);
    const char* gAb = (const char*)g.A;
    unsigned goff[2][2];
#define PG8_SA(b, h) (((b) * 2 + (h)) * HTB)
#define PG8_SB(b, h) ((4 + (b) * 2 + (h)) * HTB)
#define PG8_STAGE(bufoff, gbase, voff) do { _Pragma("unroll") for (int _i = 0; _i < 2; ++_i) \
        __builtin_amdgcn_global_load_lds((const unsigned*)((const char*)(gbase) + (voff)[_i]), (LAS unsigned*)(lds + (bufoff) + ldsw + _i * 8192), 16, 0, 0); } while (0)
#define PG8_STAGE_A(bufoff, h, base, kb) do { if constexpr (GATHER) { PG8_STAGE(bufoff, gAb + (kb), goff[h]); } else { PG8_STAGE(bufoff, (base) + (size_t)(h) * hstep + (kb), voffA); } } while (0)
#define PG8_SETG(u) do { if constexpr (GATHER) { _Pragma("unroll") for (int _h = 0; _h < 2; ++_h) _Pragma("unroll") for (int _i = 0; _i < 2; ++_i) \
        goff[_h][_i] = ((unsigned)S.row(u, _h * HALF + RA[_i]) * (unsigned)K + (unsigned)CA[_i]) * 2u; } } while (0)
#define PG8_SETG_LDS(u, slot) do { if constexpr (GATHER) { const LAS unsigned* rt_ = (const LAS unsigned*)(lds + RTK_OFF + (slot) * 1024); _Pragma("unroll") for (int _h = 0; _h < 2; ++_h) _Pragma("unroll") for (int _i = 0; _i < 2; ++_i) \
        goff[_h][_i] = ((unsigned)S.row_lds(u, _h * HALF + RA[_i], rt_) * (unsigned)K + (unsigned)CA[_i]) * 2u; } } while (0)
#define PG8_RTK(u, slot) do { if constexpr (GATHER) { if (wid == 1) { const unsigned* rp_ = S.rtk_src(u); unsigned keep_; const unsigned dst_ = (unsigned)(uintptr_t)(lds + RTK_OFF + (slot) * 1024); \
        asm volatile("s_mov_b32 %0, m0\n\ts_mov_b32 m0, %2\n\ts_nop 0\n\tglobal_load_lds_dwordx4 %1, off\n\ts_mov_b32 m0, %0" : "=&s"(keep_) : "v"(rp_ + lane * 4), "s"(dst_) : "memory"); } } } while (0)
#define PG8_LDA(dst, b, h) do { _Pragma("unroll") for (int m = 0; m < 4; ++m) dst[m] = cat8(*(const LAS bf16x8*)(lds + PG8_SA(b, h) + aoff + m * 2048), *(const LAS bf16x8*)(lds + PG8_SA(b, h) + aoff + m * 2048 + 1024)); } while (0)
#define PG8_LDB(dst, b, h) do { _Pragma("unroll") for (int n = 0; n < 2; ++n) dst[n] = cat8(*(const LAS bf16x8*)(lds + PG8_SB(b, h) + boff + n * 2048), *(const LAS bf16x8*)(lds + PG8_SB(b, h) + boff + n * 2048 + 1024)); } while (0)
#define PG8_LO(x) __builtin_bit_cast(bf16x8, __builtin_shufflevector(x, x, 0, 1, 2, 3))
#define PG8_HI(x) __builtin_bit_cast(bf16x8, __builtin_shufflevector(x, x, 4, 5, 6, 7))
#define PG8_MMA(ai, bj, At, Bt) do { __builtin_amdgcn_s_setprio(1); _Pragma("unroll") for (int m = 0; m < 4; ++m) _Pragma("unroll") for (int n = 0; n < 2; ++n) { \
        if constexpr (F8) asm volatile("v_mfma_f32_16x16x128_f8f6f4 %0, %1, %2, %0" : "+v"(acc[ai][bj][m][n]) : "v"(Bt[n]), "v"(At[m])); \
        else { acc[ai][bj][m][n] = __builtin_amdgcn_mfma_f32_16x16x32_bf16(PG8_LO(Bt[n]), PG8_LO(At[m]), acc[ai][bj][m][n], 0, 0, 0); \
               acc[ai][bj][m][n] = __builtin_amdgcn_mfma_f32_16x16x32_bf16(PG8_HI(Bt[n]), PG8_HI(At[m]), acc[ai][bj][m][n], 0, 0, 0); } } __builtin_amdgcn_s_setprio(0); } while (0)
#define PG8_WAIT_V(n) asm volatile("s_waitcnt vmcnt(" #n ")" ::: "memory")
#define PG8_WAIT_L(n) asm volatile("s_waitcnt lgkmcnt(" #n ")" ::: "memory")
#define PG8_BAR __builtin_amdgcn_s_barrier()
#define PG8_SCHED __builtin_amdgcn_sched_barrier(0)
    Unit cur, nxt; int ui = 0;
    if (!S.next(0, cur)) return;
#define PG8_RSC(u, slot) do { if (wid == 0) { const float* rp_ = E.rsc_src(u); if (rp_) { unsigned keep_; const unsigned dst_ = (unsigned)(uintptr_t)(lds + RSC_OFF + (slot) * 1024); \
        asm volatile("s_mov_b32 %0, m0\n\ts_mov_b32 m0, %2\n\ts_nop 0\n\tglobal_load_lds_dwordx4 %1, off\n\ts_mov_b32 m0, %0" : "=&s"(keep_) : "v"(rp_ + lane * 4), "s"(dst_) : "memory"); } } } while (0)
    PG8_RSC(cur, 0);
    f32x4 acc[2][2][4][2];
#pragma unroll
    for (int a = 0; a < 2; ++a)
#pragma unroll
        for (int b = 0; b < 2; ++b)
#pragma unroll
            for (int m = 0; m < 4; ++m)
#pragma unroll
                for (int n = 0; n < 2; ++n) acc[a][b][m][n] = (f32x4){0.f, 0.f, 0.f, 0.f};
    v8i At[4], B0[2], B1[2];
    const char* cA = (const char*)g.A + (size_t)cur.pm * tstep; const char* cB = (const char*)g.Bt + (size_t)cur.pn * tstep;
    PG8_SETG(cur);
    PG8_STAGE(PG8_SB(0, 0), cB, voffB); PG8_STAGE(PG8_SB(0, 1), cB + hstep, voffB); PG8_STAGE_A(PG8_SA(0, 0), 0, cA, 0); PG8_STAGE_A(PG8_SA(0, 1), 1, cA, 0);
    if (wr == 1) PG8_BAR;
    PG8_WAIT_V(2); PG8_BAR;
    PG8_STAGE(PG8_SB(1, 0), cB + kstep, voffB); PG8_STAGE_A(PG8_SA(1, 0), 0, cA, kstep); PG8_STAGE(PG8_SB(1, 1), cB + hstep + kstep, voffB);
    PG8_WAIT_V(6); PG8_BAR;
    for (;;) {
        const bool has_next = S.next(ui + 1, nxt);
        if (has_next) { PG8_RSC(nxt, (ui + 1) % 3); PG8_RTK(nxt, (ui + 1) & 1); }
        const char* nA = has_next ? (const char*)g.A + (size_t)nxt.pm * tstep : cA; const char* nB = has_next ? (const char*)g.Bt + (size_t)nxt.pn * tstep : cB;
#pragma unroll 1
        for (int t = 0; t < nt; t += 2) {
            const bool last = (t == nt - 2);
            const size_t k1 = (size_t)(t + 1) * kstep, k2 = last ? 0 : (size_t)(t + 2) * kstep, k3 = k2 + kstep;
            const char* pa2 = last ? nA : cA; const char* pb2 = last ? nB : cB;
            PG8_LDB(B0, 0, 0); PG8_LDB(B1, 0, 1); PG8_SCHED; PG8_LDA(At, 0, 0); PG8_STAGE_A(PG8_SA(1, 1), 1, cA, k1);
            if constexpr (GATHER) { if (last && has_next) PG8_SETG_LDS(nxt, (ui + 1) & 1); }
            PG8_WAIT_V(8); PG8_WAIT_L(0); PG8_BAR; PG8_MMA(0, 0, At, B0); PG8_MMA(0, 1, At, B1); PG8_BAR; PG8_SCHED;
            if (!cur.light) PG8_LDA(At, 0, 1); PG8_STAGE(PG8_SB(0, 0), pb2 + k2, voffB); PG8_STAGE(PG8_SB(0, 1), pb2 + hstep + k2, voffB); PG8_STAGE_A(PG8_SA(0, 0), 0, pa2, k2);
            PG8_WAIT_V(8); PG8_WAIT_L(0); PG8_BAR; if (!cur.light) { PG8_MMA(1, 0, At, B0); PG8_MMA(1, 1, At, B1); } PG8_BAR; PG8_SCHED;
            PG8_LDB(B0, 1, 0); PG8_LDB(B1, 1, 1); PG8_SCHED; PG8_LDA(At, 1, 0); PG8_STAGE_A(PG8_SA(0, 1), 1, pa2, k2);
            PG8_WAIT_V(8); PG8_WAIT_L(0); PG8_BAR; PG8_MMA(0, 0, At, B0); PG8_MMA(0, 1, At, B1); PG8_BAR; PG8_SCHED;
            if (!cur.light) PG8_LDA(At, 1, 1); PG8_STAGE(PG8_SB(1, 0), pb2 + k3, voffB); PG8_STAGE(PG8_SB(1, 1), pb2 + hstep + k3, voffB); PG8_STAGE_A(PG8_SA(1, 0), 0, pa2, k3);
            PG8_WAIT_V(8); PG8_WAIT_L(0); PG8_BAR; if (!cur.light) { PG8_MMA(1, 0, At, B0); PG8_MMA(1, 1, At, B1); } PG8_BAR; PG8_SCHED;
        }
        if constexpr (F8) { asm volatile("s_nop 15\n\ts_nop 15" ::: "memory"); PG8_SCHED; }
        if (wr == 0) PG8_BAR;
        E(acc, cur, wr, wc, fr, fq, (const LAS float*)(lds + RSC_OFF + (ui % 3) * 1024));
        if (!has_next) break;
#pragma unroll
        for (int a = 0; a < 2; ++a)
#pragma unroll
            for (int b = 0; b < 2; ++b)
#pragma unroll
                for (int m = 0; m < 4; ++m)
#pragma unroll
                    for (int n = 0; n < 2; ++n) acc[a][b][m][n] = (f32x4){0.f, 0.f, 0.f, 0.f};
        cur = nxt; cA = nA; cB = nB; ++ui;
        if (wr == 1) PG8_BAR;
    }
    PG8_WAIT_V(0);
    PG8_BAR;
#undef PG8_SA
#undef PG8_SB
#undef PG8_STAGE
#undef PG8_STAGE_A
#undef PG8_SETG
#undef PG8_SETG_LDS
#undef PG8_RTK
#undef PG8_LDA
#undef PG8_LDB
#undef PG8_RSC
#undef PG8_LO
#undef PG8_HI
#undef PG8_MMA
#undef PG8_WAIT_V
#undef PG8_WAIT_L
#undef PG8_BAR
#undef PG8_SCHED
}

struct EpiZ {
    static constexpr bool PERM = true;
    bf16* Z; const float* rs; const LAS float* gz;
    __device__ __forceinline__ const float* rsc_src(const Unit& u) const { return rs + (size_t)u.pm * BM; }
    __device__ __forceinline__ void operator()(const f32x4 (&acc)[2][2][4][2], const Unit& u, int wr, int wc, int fr, int fq, const LAS float* rsc) const {
        const int pn = u.pn;
        const LAS float* gp = pn < 2 ? gz : (pn < 4 ? gz + 64 : (pn == 7 ? gz + 128 : nullptr));
        f32x4 gv[2][2];
#pragma unroll
        for (int bj = 0; bj < 2; ++bj)
#pragma unroll
            for (int n = 0; n < 2; ++n) gv[bj][n] = gp ? *(const LAS f32x4*)(gp + 32 * bj + 8 * fq + 4 * n) : (f32x4){1.f, 1.f, 1.f, 1.f};
        const int col0 = 256 * pn + 64 * wc + 8 * fq;
#pragma unroll
        for (int ai = 0; ai < 2; ++ai)
#pragma unroll
            for (int m = 0; m < 4; ++m) {
                const int rl = ai * HALF + wr * 64 + m * 16 + fr, row = u.pm * BM + rl; const float r = rsc[rl];
                f32x4 v[2][2]; float ss = 0.f;
#pragma unroll
                for (int bj = 0; bj < 2; ++bj)
#pragma unroll
                    for (int n = 0; n < 2; ++n) { v[bj][n] = acc[ai][bj][m][n] * r; const f32x4 q = v[bj][n] * v[bj][n]; ss += (q[0] + q[1]) + (q[2] + q[3]); }
                if (gp) { ss += __shfl_xor(ss, 16); ss += __shfl_xor(ss, 32); const float rn = 1.0f / sqrtf(ss * (1.f / 64.f) + EPS);
#pragma unroll
                    for (int bj = 0; bj < 2; ++bj)
#pragma unroll
                        for (int n = 0; n < 2; ++n) v[bj][n] = v[bj][n] * rn * gv[bj][n]; }
                bf16* rowp = Z + ((size_t)(4 * pn + wc) * T + row) * 64 + 8 * fq;
#pragma unroll
                for (int bj = 0; bj < 2; ++bj) { u32x4 w; w.x = pk2(v[bj][0][0], v[bj][0][1]); w.y = pk2(v[bj][0][2], v[bj][0][3]); w.z = pk2(v[bj][1][0], v[bj][1][1]); w.w = pk2(v[bj][1][2], v[bj][1][3]);
                    *(u32x4*)(rowp + 32 * bj) = w; }
            }
    }
};
struct EpiX1 {
    static constexpr bool PERM = true;
    const bf16* xb; bf16* x1b; float* ssq;
    __device__ __forceinline__ const float* rsc_src(const Unit&) const { return nullptr; }
    __device__ __forceinline__ void operator()(const f32x4 (&acc)[2][2][4][2], const Unit& u, int wr, int wc, int fr, int fq, const LAS float*) const {
        const int col0 = u.pn * BM + wc * 32 + 8 * fq;
#pragma unroll
        for (int ai = 0; ai < 2; ++ai)
#pragma unroll
            for (int m = 0; m < 4; ++m) {
                const int row = u.pm * BM + ai * HALF + wr * 64 + m * 16 + fr; const size_t off = (size_t)row * DM + col0; float ss = 0.f;
#pragma unroll
                for (int bj = 0; bj < 2; ++bj) { f32x4 x1[2]; const u32x4 xw = *(const u32x4*)(xb + off + bj * HALF);
                    x1[0] = (f32x4){bflo(xw.x), bfhi(xw.x), bflo(xw.y), bfhi(xw.y)} + acc[ai][bj][m][0]; x1[1] = (f32x4){bflo(xw.z), bfhi(xw.z), bflo(xw.w), bfhi(xw.w)} + acc[ai][bj][m][1];
#pragma unroll
                    for (int n = 0; n < 2; ++n) { const f32x4 q = x1[n] * x1[n]; ss += (q[0] + q[1]) + (q[2] + q[3]); }
                    u32x4 w; w.x = pk2(x1[0][0], x1[0][1]); w.y = pk2(x1[0][2], x1[0][3]); w.z = pk2(x1[1][0], x1[1][1]); w.w = pk2(x1[1][2], x1[1][3]);
                    *(u32x4*)(x1b + off + bj * HALF) = w; }
                ss += __shfl_xor(ss, 16); ss += __shfl_xor(ss, 32);
                if (fq == 0) ssq[(size_t)row * 16 + u.pn * 4 + wc] = ss;
            }
    }
};
struct EpiH {
    static constexpr bool PERM = true;
    unsigned char* H; const float* rowrstd;
    __device__ __forceinline__ const float* rsc_src(const Unit& u) const { return rowrstd + (size_t)u.e * CAP + u.mt * 256; }
    __device__ __forceinline__ void operator()(const f32x4 (&acc)[2][2][4][2], const Unit& u, int wr, int wc, int fr, int fq, const LAS float* rsc) const {
        const int pnl = u.pn & 3, col0 = 128 * pnl + 32 * wc + 8 * fq;
#pragma unroll
        for (int ai = 0; ai < 2; ++ai) { if (ai == 1 && u.light) break;
#pragma unroll
            for (int m = 0; m < 4; ++m) {
                const int rl = ai * HALF + wr * 64 + m * 16 + fr, idx = u.mt * 256 + rl; const bool valid = idx < u.cnt;
                const float rs = valid ? rsc[rl] * (1.0f / W13_SCALE) : 0.f;
                float h[8];
#pragma unroll
                for (int n = 0; n < 2; ++n)
#pragma unroll
                    for (int e = 0; e < 4; ++e) { const float a = acc[ai][0][m][n][e] * rs, b = acc[ai][1][m][n][e] * rs;
                        const float sg = __builtin_amdgcn_rcpf(1.0f + __builtin_amdgcn_exp2f(-1.4426950408889634f * a)); h[4 * n + e] = a * sg * b * H_SCALE; }
                u32x2 w; w.x = pk4f8(h[0], h[1], h[2], h[3]); w.y = pk4f8(h[4], h[5], h[6], h[7]);
                *(u32x2*)(H + (size_t)(u.pm * BM + rl) * EH + col0) = w;
            } }
    }
};
struct EpiY {
    static constexpr bool PERM = true;
    bf16* Y; const float* rowgate; const LAS int* tab;
    __device__ __forceinline__ const float* rsc_src(const Unit& u) const { return rowgate + (size_t)u.e * CAP + u.mt * 256; }
    __device__ __forceinline__ void operator()(const f32x4 (&acc)[2][2][4][2], const Unit& u, int wr, int wc, int fr, int fq, const LAS float* rsc) const {
        const int pnl = u.pn & 3, col0 = 256 * pnl + 32 * wc + 8 * fq;
#pragma unroll
        for (int ai = 0; ai < 2; ++ai) { if (ai == 1 && u.light) break;
#pragma unroll
            for (int m = 0; m < 4; ++m) {
                const int rl = ai * HALF + wr * 64 + m * 16 + fr, idx = u.mt * 256 + rl; const bool valid = idx < u.cnt;
                const float gt = valid ? rsc[rl] * (1.0f / (W2_SCALE * H_SCALE)) : 0.f;
                if (!valid) continue;
                bf16* rowp = Y + (size_t)(tab[259 + u.e] + idx) * DM + col0;
#pragma unroll
                for (int bj = 0; bj < 2; ++bj) { const f32x4 v0 = acc[ai][bj][m][0] * gt, v1 = acc[ai][bj][m][1] * gt;
                    u32x4 w; w.x = pk2(v0[0], v0[1]); w.y = pk2(v0[2], v0[3]); w.z = pk2(v1[0], v1[1]); w.w = pk2(v1[2], v1[3]); *(u32x4*)(rowp + bj * HALF) = w; }
            } }
    }
};
}

#define XB_TMO      128
#define XB_XCNT(j)  (256  + 64 * (j))
#define XB_XSUB(j)  (1280 + 64 * (j))
#define XB_XGEN(j)  (2304 + 64 * (j))
#define XB_TOP      3328
#define XB_TOPGEN   3392
#define XCD_BAR_WORDS 3456
#define XB_SPIN_CAP (1u << 18)
__device__ __forceinline__ unsigned xb_ld(unsigned* p)              { return __hip_atomic_load(p, __ATOMIC_RELAXED, __HIP_MEMORY_SCOPE_AGENT); }
__device__ __forceinline__ unsigned xb_add(unsigned* p, unsigned v) { return __hip_atomic_fetch_add(p, v, __ATOMIC_RELAXED, __HIP_MEMORY_SCOPE_AGENT); }
__device__ __forceinline__ unsigned xb_xcc_id() { return (unsigned)__builtin_amdgcn_s_getreg((3 << 11) | 20) & 0xFu; }
#define XB_SPIN(cond, bar) do { unsigned _sp = 0; while (cond) { __builtin_amdgcn_s_sleep(1); \
    if ((++_sp & 255u) == 0u) { if (xb_ld(&(bar)[XB_TMO])) break; if (_sp > XB_SPIN_CAP) { atomicAdd(&(bar)[XB_TMO], 1u); break; } } } } while (0)
struct XcdBarrier { unsigned* bar; unsigned x; volatile LAS unsigned* st; };
__device__ __forceinline__ XcdBarrier xcd_barrier_post(unsigned* bar, volatile LAS unsigned* st) {
    XcdBarrier b; b.bar = bar; b.x = xb_xcc_id(); b.st = st;
    if (threadIdx.x == 0) (void)xb_add(&bar[XB_XCNT(b.x)], 1u);
    return b;
}
__device__ __forceinline__ void xcd_barrier_complete(unsigned* bar, unsigned x, unsigned& nloc, unsigned& nx) {
    const unsigned G = gridDim.x * gridDim.y * gridDim.z;
    unsigned sum, cnt, mine, sp = 0u;
    for (;;) {
        sum = 0u; cnt = 0u; mine = 0u;
#pragma unroll
        for (unsigned j = 0; j < 16; ++j) { const unsigned c = xb_ld(&bar[XB_XCNT(j)]); sum += c; cnt += (c > 0u) ? 1u : 0u; mine = (j == x) ? c : mine; }
        if (sum == G) break;
        __builtin_amdgcn_s_sleep(1);
        if ((++sp & 255u) == 0u) { if (xb_ld(&bar[XB_TMO])) break; if (sp > XB_SPIN_CAP) { atomicAdd(&bar[XB_TMO], 1u); break; } }
    }
    nloc = mine > 0u ? mine : 1u; nx = cnt > 0u ? cnt : 1u;
}
__device__ __forceinline__ void xcd_barrier(const XcdBarrier& b) {
    asm volatile("s_waitcnt vmcnt(0)" ::: "memory");
    __syncthreads();
    if (threadIdx.x == 0) {
        unsigned* bar = b.bar;
        __builtin_amdgcn_s_waitcnt(0);
        unsigned nloc = b.st[0], nx = b.st[1];
        if (nloc == 0u) { xcd_barrier_complete(bar, b.x, nloc, nx); b.st[0] = nloc; b.st[1] = nx; }
        const unsigned old = xb_add(&bar[XB_XSUB(b.x)], 1u);
        const unsigned gen = old / nloc;
        if (old + 1u == (gen + 1u) * nloc) {
            __builtin_amdgcn_fence(__ATOMIC_RELEASE, "agent");
            asm volatile("s_waitcnt vmcnt(0)" ::: "memory");
            const unsigned og = xb_add(&bar[XB_TOP], 1u);
            const unsigned tg = og / nx;
            if (og + 1u == (tg + 1u) * nx) xb_add(&bar[XB_TOPGEN], 1u);
            else XB_SPIN(xb_ld(&bar[XB_TOPGEN]) == tg, bar);
            __builtin_amdgcn_fence(__ATOMIC_ACQUIRE, "agent");
            xb_add(&bar[XB_XGEN(b.x)], 1u);
            asm volatile("s_waitcnt vmcnt(0)" ::: "memory");
        } else {
            XB_SPIN(xb_ld(&bar[XB_XGEN(b.x)]) == gen, bar);
            __builtin_amdgcn_fence(__ATOMIC_ACQUIRE, "agent");
            asm volatile("s_waitcnt vmcnt(0)" ::: "memory");
        }
    }
    __syncthreads();
}

struct XbTicket { unsigned last, gen, tg; };
__device__ __forceinline__ XbTicket xcd_barrier_arrive(const XcdBarrier& b) {
    asm volatile("s_waitcnt vmcnt(0)" ::: "memory");
    __syncthreads();
    XbTicket t; t.last = 0u; t.gen = 0u; t.tg = 0u;
    if (threadIdx.x == 0) {
        unsigned* bar = b.bar;
        __builtin_amdgcn_s_waitcnt(0);
        unsigned nloc = b.st[0], nx = b.st[1];
        if (nloc == 0u) { xcd_barrier_complete(bar, b.x, nloc, nx); b.st[0] = nloc; b.st[1] = nx; }
        const unsigned old = xb_add(&bar[XB_XSUB(b.x)], 1u);
        t.gen = old / nloc;
        if (old + 1u == (t.gen + 1u) * nloc) {
            t.last = 1u;
            __builtin_amdgcn_fence(__ATOMIC_RELEASE, "agent");
            asm volatile("s_waitcnt vmcnt(0)" ::: "memory");
            const unsigned og = xb_add(&bar[XB_TOP], 1u);
            t.tg = og / nx;
            if (og + 1u == (t.tg + 1u) * nx) { xb_add(&bar[XB_TOPGEN], 1u); t.last = 2u; }
        }
    }
    return t;
}
__device__ __forceinline__ void xcd_barrier_wait(const XcdBarrier& b, const XbTicket& t) {
    asm volatile("s_waitcnt vmcnt(0)" ::: "memory");
    if (threadIdx.x == 0) {
        unsigned* bar = b.bar;
        if (t.last != 0u) {
            if (t.last == 1u) XB_SPIN(xb_ld(&bar[XB_TOPGEN]) == t.tg, bar);
            __builtin_amdgcn_fence(__ATOMIC_ACQUIRE, "agent");
            xb_add(&bar[XB_XGEN(b.x)], 1u);
            asm volatile("s_waitcnt vmcnt(0)" ::: "memory");
        } else {
            XB_SPIN(xb_ld(&bar[XB_XGEN(b.x)]) == t.gen, bar);
            __builtin_amdgcn_fence(__ATOMIC_ACQUIRE, "agent");
            asm volatile("s_waitcnt vmcnt(0)" ::: "memory");
        }
    }
    __syncthreads();
}

struct Args { const float* in[21]; float* out; unsigned char* ws; unsigned char* wsh; int ph_lo, ph_hi; };
struct Frame {
    LAS unsigned char* lds; int tid, lane, wave, vcu, G;
    const float* in[21]; float* out; unsigned char* ws; unsigned char* wsh;
};

__device__ __forceinline__ void p0_item(const float* W, int N, const float* gain, int k0, int n0, bf16* WT, int Kd, size_t drow0, LAS float* scr, int lane) {
    float v[32];
#pragma unroll
    for (int i = 0; i < 32; ++i) v[i] = __builtin_nontemporal_load(W + (size_t)(k0 + 2 * i + (lane >> 5)) * N + n0 + (lane & 31));
#pragma unroll
    for (int i = 0; i < 32; ++i) { const int kk = 2 * i + (lane >> 5); float t = v[i]; if (gain) t *= gain[k0 + kk]; scr[kk * 33 + (lane & 31)] = t; }
    LDS_WAIT(); asm volatile("" ::: "memory");
    const int c = lane & 7;
#pragma unroll
    for (int j = 0; j < 4; ++j) { const int n = (lane >> 3) + 8 * j; const LAS float* s = scr + (8 * c) * 33 + n;
        u32x4 o; o.x = pk2(s[0 * 33], s[1 * 33]); o.y = pk2(s[2 * 33], s[3 * 33]); o.z = pk2(s[4 * 33], s[5 * 33]); o.w = pk2(s[6 * 33], s[7 * 33]);
        *(GAS u32x4*)(WT + (drow0 + n) * (size_t)Kd + k0 + 8 * c) = o; }
    LDS_WAIT(); asm volatile("" ::: "memory");
}
__device__ __forceinline__ void p0_poolfold_item(const float* Wout, const float* proj, const float* scale, int item, bf16* WT, LAS float* scr, int lane) {
    const int g = item >> 7, cb = (item >> 4) & 7, nb = item & 15, n = nb * 64 + lane, c0 = cb * 8;
    float acc[8];
#pragma unroll
    for (int j = 0; j < 8; ++j) acc[j] = 0.f;
    { const float* prg = proj + (size_t)(g * 64 + c0) * 64; const f32x4 p0 = *(const f32x4*)(prg + 8 * lane), p1 = *(const f32x4*)(prg + 8 * lane + 4);
      *(LAS f32x4*)(scr + 8 * lane) = p0; *(LAS f32x4*)(scr + 8 * lane + 4) = p1;
      if (lane < 16) *(LAS f32x4*)(scr + 512 + 4 * lane) = *(const f32x4*)(scale + 64 * g + 4 * lane); }
    const LAS float* pr = scr; const LAS float* scl = scr + 512;
    float wo[64];
#pragma unroll
    for (int e = 0; e < 64; ++e) wo[e] = __builtin_nontemporal_load(Wout + (size_t)(512 + 64 * g + e) * DM + n);
    LDS_WAIT(); asm volatile("" ::: "memory");
#pragma unroll
    for (int e = 0; e < 64; ++e) { const float w = wo[e] * scl[e];
#pragma unroll
        for (int j = 0; j < 8; ++j) acc[j] += pr[j * 64 + e] * w; }
    u32x4 o; o.x = pk2(acc[0], acc[1]); o.y = pk2(acc[2], acc[3]); o.z = pk2(acc[4], acc[5]); o.w = pk2(acc[6], acc[7]);
    *(GAS u32x4*)(WT + (size_t)n * DM + 512 + 64 * g + c0) = o;
    LDS_WAIT(); asm volatile("" ::: "memory");
}
__device__ __forceinline__ void p0_xrow(const float* xrow, bf16* orow, float* rs, int lane) {
    const GAS f32x4* xr = (const GAS f32x4*)xrow + lane;
    f32x4 v[4]; float s = 0.f;
#pragma unroll
    for (int j = 0; j < 4; ++j) { v[j] = xr[64 * j]; s += (v[j].x * v[j].x + v[j].y * v[j].y) + (v[j].z * v[j].z + v[j].w * v[j].w); }
    s = wave_sum(s);
    if (lane == 0) *rs = 1.0f / sqrtf(s * (1.f / DM) + EPS);
    GAS unsigned long long* o8 = (GAS unsigned long long*)orow + lane;
#pragma unroll
    for (int j = 0; j < 4; ++j) o8[64 * j] = (unsigned long long)pk2(v[j].x, v[j].y) | ((unsigned long long)pk2(v[j].z, v[j].w) << 32);
}
__device__ __forceinline__ void p0_memkv(Frame& F, int task, LAS float* myscr, LAS float* allscr  ) {
    const float* mem = F.in[1]; const float* mnorm = F.in[8]; const float* wkv = F.in[9]; const float* mkn = F.in[11];
    bf16* kvm = (bf16*)(F.ws + WS_KVM);
    const int lane = F.lane, i = lane & 15, kk = lane >> 4, kq = F.wave;
    const int rb = task >> 3, cb = task & 7;
    f32x4 acc[2][4];
#pragma unroll
    for (int mb = 0; mb < 2; ++mb)
#pragma unroll
        for (int nb = 0; nb < 4; ++nb) acc[mb][nb] = (f32x4){0.f, 0.f, 0.f, 0.f};
    float ss0 = 0.f, ss1 = 0.f;
    const float* arow = mem + (size_t)(rb * 32 + i) * DM;
    const float* wb = wkv + cb * 64 + i;
#pragma unroll 1
    for (int st = 0; st < 4; ++st) {
        const int k0 = 128 * kq + 32 * st + 8 * kk;
        const f32x4 a0 = *(const f32x4*)(arow + k0), a1 = *(const f32x4*)(arow + k0 + 4), c0 = *(const f32x4*)(arow + 16 * DM + k0), c1 = *(const f32x4*)(arow + 16 * DM + k0 + 4);
        const f32x4 g0 = *(const f32x4*)(mnorm + k0), g1 = *(const f32x4*)(mnorm + k0 + 4);
        float bv[4][8];
#pragma unroll
        for (int nb = 0; nb < 4; ++nb)
#pragma unroll
            for (int j = 0; j < 8; ++j) bv[nb][j] = wb[(size_t)(k0 + j) * 512 + nb * 16];
        ss0 += ((a0[0] * a0[0] + a0[1] * a0[1]) + (a0[2] * a0[2] + a0[3] * a0[3])) + ((a1[0] * a1[0] + a1[1] * a1[1]) + (a1[2] * a1[2] + a1[3] * a1[3]));
        ss1 += ((c0[0] * c0[0] + c0[1] * c0[1]) + (c0[2] * c0[2] + c0[3] * c0[3])) + ((c1[0] * c1[0] + c1[1] * c1[1]) + (c1[2] * c1[2] + c1[3] * c1[3]));
        const f32x4 p0 = a0 * g0, p1 = a1 * g1, q0 = c0 * g0, q1 = c1 * g1;
        u32x4 aw; aw.x = pk2(p0[0], p0[1]); aw.y = pk2(p0[2], p0[3]); aw.z = pk2(p1[0], p1[1]); aw.w = pk2(p1[2], p1[3]);
        u32x4 cw; cw.x = pk2(q0[0], q0[1]); cw.y = pk2(q0[2], q0[3]); cw.z = pk2(q1[0], q1[1]); cw.w = pk2(q1[2], q1[3]);
        const bf16x8 a8 = __builtin_bit_cast(bf16x8, aw), c8 = __builtin_bit_cast(bf16x8, cw);
#pragma unroll
        for (int nb = 0; nb < 4; ++nb) { u32x4 bw; bw.x = pk2(bv[nb][0], bv[nb][1]); bw.y = pk2(bv[nb][2], bv[nb][3]); bw.z = pk2(bv[nb][4], bv[nb][5]); bw.w = pk2(bv[nb][6], bv[nb][7]);
            acc[0][nb] = __builtin_amdgcn_mfma_f32_16x16x32_bf16(a8, __builtin_bit_cast(bf16x8, bw), acc[0][nb], 0, 0, 0);
            acc[1][nb] = __builtin_amdgcn_mfma_f32_16x16x32_bf16(c8, __builtin_bit_cast(bf16x8, bw), acc[1][nb], 0, 0, 0); }
    }
#pragma unroll
    for (int mb = 0; mb < 2; ++mb)
#pragma unroll
        for (int nb = 0; nb < 4; ++nb)
#pragma unroll
            for (int r = 0; r < 4; ++r) myscr[((mb * 4 + nb) * 4 + r) * 64 + lane] = acc[mb][nb][r];
    myscr[2048 + lane] = ss0; myscr[2048 + 64 + lane] = ss1;
    LDS_WAIT(); __syncthreads();
    if (kq < 2) {
        const int mb = kq;
        float ssum = 0.f;
#pragma unroll
        for (int w = 0; w < 8; ++w) ssum += allscr[w * 4096 + 2048 + mb * 64 + lane];
        ssum += __shfl_xor(ssum, 16); ssum += __shfl_xor(ssum, 32);
        const float rsm = 1.0f / sqrtf(ssum * (1.f / DM) + EPS);
        float v[4][4];
#pragma unroll
        for (int nb = 0; nb < 4; ++nb)
#pragma unroll
            for (int r = 0; r < 4; ++r) { float s = 0.f;
#pragma unroll
                for (int w = 0; w < 8; ++w) s += allscr[w * 4096 + ((mb * 4 + nb) * 4 + r) * 64 + lane];
                v[nb][r] = s; }
#pragma unroll
        for (int r = 0; r < 4; ++r) { const int rowD = 4 * kk + r; const float rr = __shfl(rsm, rowD);
#pragma unroll
            for (int nb = 0; nb < 4; ++nb) v[nb][r] *= rr; }
        if (cb < 4) {
#pragma unroll
            for (int r = 0; r < 4; ++r) { float s2 = 0.f;
#pragma unroll
                for (int nb = 0; nb < 4; ++nb) s2 += v[nb][r] * v[nb][r];
                s2 += __shfl_xor(s2, 1); s2 += __shfl_xor(s2, 2); s2 += __shfl_xor(s2, 4); s2 += __shfl_xor(s2, 8);
                const float rn = 1.0f / sqrtf(s2 * (1.f / 64.f) + EPS);
#pragma unroll
                for (int nb = 0; nb < 4; ++nb) v[nb][r] *= rn * mkn[nb * 16 + i]; }
        }
#pragma unroll
        for (int r = 0; r < 4; ++r)
#pragma unroll
            for (int nb = 0; nb < 4; ++nb) kvm[(size_t)(rb * 32 + mb * 16 + 4 * kk + r) * 512 + cb * 64 + nb * 16 + i] = (bf16)f2bf(v[nb][r]);
    }
    __syncthreads();
}

__device__ __forceinline__ void p0_prologue(Frame& F) {
    LAS float* scr = (LAS float*)(F.lds + F.wave * 16384);
    const int gw = F.vcu * 8 + F.wave, NGW = F.G * 8;
    for (int t2 = F.vcu; t2 < 256; t2 += F.G) p0_memkv(F, t2, scr, (LAS float*)F.lds);
    const float* attn_norm = F.in[2]; const float* w_in = F.in[3]; const float* w_out = F.in[12];
    bf16* WinT = (bf16*)(F.ws + WS_WIN); bf16* WoutT = (bf16*)(F.ws + WS_WOUT);
    constexpr int I_IN = 16 * 64, I_OUT = 12 * 32, I_FOLD = 512;
    constexpr int NITEMS = I_IN + I_OUT + I_FOLD;
    for (int it = gw; it < NITEMS; it += NGW) {
        int r = (it & 7) * (NITEMS / 8) + (it >> 3);
        if (r < I_IN) { const int kb = r >> 6, nb = r & 63, n0 = nb * 32;
            const int pn = n0 >> 8, wc = (n0 >> 6) & 3, bj = (n0 >> 5) & 1; const size_t drow = (size_t)(256 * pn + 128 * bj + 32 * wc);
            p0_item(w_in, INW, attn_norm, kb * 64, n0, WinT, DM, drow, scr, F.lane); continue; }
        r -= I_IN;
        if (r < I_OUT) { int kb = r >> 5; const int nb = r & 31; if (kb >= 8) kb += 4;
            p0_item(w_out, DM, nullptr, kb * 64, nb * 32, WoutT, DM, (size_t)nb * 32, scr, F.lane); continue; }
        r -= I_OUT;
        p0_poolfold_item(w_out, F.in[6], F.in[7], r, WoutT, scr, F.lane);
    }
    const int gt = F.vcu * 512 + F.tid, NGT = F.G * 512;
    float rtv = 0.f, rtg = 0.f;
    if (gt < 96 * 1024) { const int j = gt >> 10, k = gt & 1023; const float* wg = F.in[14]; const float* wr = F.in[16];
        if (j < 8) rtv = wg[k * 8 + j]; else if (j < 72) rtv = wr[(size_t)((j - 8) >> 3) * 8192 + k * 8 + ((j - 8) & 7)];
        rtg = F.in[13][k]; }
    { const float* x = F.in[0]; bf16* XB = (bf16*)(F.wsh + WS_XB); float* RS = (float*)(F.ws + WS_RS);
      for (int m = gw; m < T; m += 2 * NGW) {
          const int m2 = m + NGW; const bool has2 = m2 < T;
          const GAS f32x4* xa = (const GAS f32x4*)(x + (size_t)m * DM) + F.lane; const GAS f32x4* xb2 = (const GAS f32x4*)(x + (size_t)(has2 ? m2 : m) * DM) + F.lane;
          f32x4 va[4], vb[4]; float sa = 0.f, sb = 0.f;
#pragma unroll
          for (int j = 0; j < 4; ++j) { va[j] = __builtin_nontemporal_load(&xa[64 * j]); vb[j] = __builtin_nontemporal_load(&xb2[64 * j]); }
#pragma unroll
          for (int j = 0; j < 4; ++j) { sa += (va[j].x * va[j].x + va[j].y * va[j].y) + (va[j].z * va[j].z + va[j].w * va[j].w); sb += (vb[j].x * vb[j].x + vb[j].y * vb[j].y) + (vb[j].z * vb[j].z + vb[j].w * vb[j].w); }
          sa = wave_sum(sa); sb = wave_sum(sb);
          if (F.lane == 0) { RS[m] = 1.0f / sqrtf(sa * (1.f / DM) + EPS); if (has2) RS[m2] = 1.0f / sqrtf(sb * (1.f / DM) + EPS); }
          GAS unsigned long long* oa = (GAS unsigned long long*)(XB + (size_t)m * DM) + F.lane;
#pragma unroll
          for (int j = 0; j < 4; ++j) oa[64 * j] = (unsigned long long)pk2(va[j].x, va[j].y) | ((unsigned long long)pk2(va[j].z, va[j].w) << 32);
          if (has2) { GAS unsigned long long* ob = (GAS unsigned long long*)(XB + (size_t)m2 * DM) + F.lane;
#pragma unroll
              for (int j = 0; j < 4; ++j) ob[64 * j] = (unsigned long long)pk2(vb[j].x, vb[j].y) | ((unsigned long long)pk2(vb[j].z, vb[j].w) << 32); } } }
    { bf16* RT = (bf16*)(F.ws + WS_RT); const float* wg = F.in[14]; const float* wr = F.in[16];
      for (int idx = gt; idx < 96 * 1024; idx += NGT) { const int j = idx >> 10, k = idx & 1023; float v = 0.f, gn;
          if (idx == gt) { v = rtv; gn = rtg; }
          else { if (j < 8) v = wg[k * 8 + j]; else if (j < 72) v = wr[(size_t)((j - 8) >> 3) * 8192 + k * 8 + ((j - 8) & 7)]; gn = F.in[13][k]; }
          const int kq = k >> 8, st = (k >> 4) & 15, hi2 = (k >> 3) & 1, nb = j >> 5, ln = (j & 31) + 32 * hi2;
          RT[(size_t)((((kq * 16 + st) * 3 + nb) * 64 + ln) * 8 + (k & 7))] = (bf16)f2bf(v * gn); }
    }
}

template <int NQ>
__device__ __forceinline__ void cv_item_f8(const float* W, int N, const LAS float* gain, float scale, int k0, int n0, unsigned char* WT, int Kd, size_t drow0, LAS unsigned* scr, int lane) {
    const int g = lane >> 4, nq = lane & 15;
#pragma unroll 1
    for (int qp = 0; qp < NQ; qp += 2) {
        const int kh = k0 + 64 * qp;
        const float* wp = W + (size_t)(kh + 4 * g) * N + n0 + 4 * nq;
        f32x4 v[8][4];
#pragma unroll
        for (int j = 0; j < 8; ++j)
#pragma unroll
            for (int r = 0; r < 4; ++r) v[j][r] = __builtin_nontemporal_load((const f32x4*)(wp + (size_t)(16 * j + r) * N));
#pragma unroll
        for (int j = 0; j < 8; ++j) {
            f32x4 s4 = {scale, scale, scale, scale};
            if (gain) s4 = *(const LAS f32x4*)(gain + kh + 16 * j + 4 * g) * scale;
            const int kq = 16 * qp + 4 * j + g, x = 2 * (4 * qp + j);
            unsigned d[4];
#pragma unroll
            for (int c = 0; c < 4; ++c) d[c] = pk4f8(v[j][0][c] * s4[0], v[j][1][c] * s4[1], v[j][2][c] * s4[2], v[j][3][c] * s4[3]);
            u32x4 o;
            if (j & 1) { o.x = d[2]; o.y = d[3]; o.z = d[0]; o.w = d[1]; } else { o.x = d[0]; o.y = d[1]; o.z = d[2]; o.w = d[3]; }
            *(LAS u32x4*)(scr + kq * 64 + ((4 * nq) ^ (x & 28))) = o;
        }
    }
    LDS_WAIT(); asm volatile("" ::: "memory");
    constexpr int NC = 4 * NQ;
    const int c = lane % NC;
#pragma unroll
    for (int j = 0; j < NC; ++j) { const int n = lane / NC + (64 / NC) * j; const LAS unsigned* sp = scr + (4 * c) * 64 + (n ^ (2 * c));
        u32x4 o; o.x = sp[0]; o.y = sp[64]; o.z = sp[128]; o.w = sp[192];
        *(GAS u32x4*)(WT + (drow0 + n) * (size_t)Kd + k0 + 16 * c) = o; }
    LDS_WAIT(); asm volatile("" ::: "memory");
}
template <int PART>
__device__ __forceinline__ void expert_convert(Frame& F) {
    LAS unsigned* scr = (LAS unsigned*)(F.lds + F.wave * 16384);
    const int gw = F.vcu * 8 + F.wave, NGW = F.G * 8;
    unsigned char* W13Q = F.wsh + WS_W13; unsigned char* W2Q = F.wsh + WS_W2;
    if constexpr (PART == 0) {
        constexpr int I_E1 = 4 * 8;
        LAS float* gl = (LAS float*)(F.lds + RSC_OFF);
        for (int i = F.tid; i < DM; i += 512) gl[i] = F.in[13][i];
        LDS_WAIT(); __syncthreads();
        for (int r = gw; r < NEXP * 2 * I_E1; r += NGW) {
            const int e = r / (2 * I_E1); int q = r % (2 * I_E1);
            const int s = q >= I_E1; q -= s * I_E1; const int kb = q >> 3, nb = q & 7, f0 = nb * 64;
            const float* W = (s ? F.in[19] : F.in[18]) + (size_t)e * DM * EH;
            const size_t drow = (size_t)e * 1024 + 256 * (f0 >> 7) + 128 * s + (f0 & 127);
            cv_item_f8<4>(W, EH, gl, W13_SCALE, kb * 256, f0, W13Q, DM, drow, scr, F.lane); }
    } else {
        constexpr int I_E2 = 4 * 16, QITEMS = NEXP * I_E2 / 4;
        if ((F.wave & 1) != (PART & 1)) return;
        for (int r0 = gw >> 1; r0 < QITEMS; r0 += NGW / 2) {
            const int r = r0 + (PART - 1) * QITEMS;
            const int e = r / I_E2, q = r % I_E2, kb = q >> 4, nb = q & 15;
            const float* W = F.in[20] + (size_t)e * EH * DM;
            cv_item_f8<2>(W, DM, nullptr, W2_SCALE, kb * 128, nb * 64, W2Q, EH, (size_t)e * 1024 + nb * 64, scr, F.lane); }
    }
}

__device__ __forceinline__ void cv_w13_queue(Frame& F) {
    unsigned* q = (unsigned*)(F.ws + WS_CTL) + CW_Q13;
    volatile LAS unsigned* slot = (volatile LAS unsigned*)(F.lds + MISC_OFF + 136);
    LAS unsigned* scr = (LAS unsigned*)(F.lds + F.wave * 16384);
    LAS float* gl = (LAS float*)(F.lds + RSC_OFF);
    for (int i = F.tid; i < DM; i += 512) gl[i] = F.in[13][i];
    int lane = F.lane; asm volatile("" : "+v"(lane));
    constexpr unsigned NIT = NEXP * 128;
    for (int it = 0;; ++it) {
        if (F.tid == 0) slot[it & 1] = __hip_atomic_fetch_add(q, 8u, RLX_AGENT);
        LDS_WAIT(); __syncthreads();
        const unsigned base = slot[it & 1];
        if (base >= NIT) break;
        const unsigned j = base + (unsigned)F.wave;
        const int e = (int)(j >> 7); int qq = (int)(j & 127); const int sx = qq >> 6; qq &= 63; const int kb = qq >> 3, nb = qq & 7, f0 = nb * 64;
        const float* W = (sx ? F.in[19] : F.in[18]) + (size_t)e * DM * EH;
        const size_t drow = (size_t)e * 1024 + 256 * (f0 >> 7) + 128 * sx + (f0 & 127);
        cv_item_f8<2>(W, EH, gl, W13_SCALE, kb * 128, f0, F.wsh + WS_W13, DM, drow, scr, lane);
    }
    LDS_WAIT();
}

struct ATask { const bf16* qp; const bf16* kp; const bf16* vp; bf16* op; float* lp; long qstride, kvstride, ostride; int kfirst, jmin, jmax, lstride; };
__device__ __forceinline__ ATask p2_make_task(const Frame& F, int t, int b, int ci, int h) {
    const bf16* Z = (const bf16*)(F.wsh + WS_Z); const bf16* KVM = (const bf16*)(F.ws + WS_KVM); bf16* MIX = (bf16*)(F.wsh + WS_MIX);
    bf16* PO = (bf16*)(F.wsh + WS_PO); float* LP = (float*)(F.ws + WS_LP);
    ATask a; const long rowbase = (long)b * SEQ; const int s0 = ci * 512;
    if (t == 0) { const int mh = h & 3, sb = 8 * (h >> 2) + F.wave; const long tok0 = rowbase + s0 + 32 * sb;
        a.qp = Z + ((size_t)(28 + mh) * T + tok0) * 64; a.qstride = 64; a.kp = KVM + (size_t)b * NMEM * 512 + 64 * mh; a.vp = a.kp + 256; a.kvstride = 512; a.kfirst = 0; a.jmin = 0; a.jmax = 7;
        a.op = MIX + tok0 * DM + 768 + 64 * mh; a.ostride = DM; a.lp = nullptr; a.lstride = 0; }
    else { const int pat = (t - 1) >> 1, half = (t - 1) & 1, dil = pat == 0 ? 1 : (pat == 1 ? 4 : 16), tk = F.wave + 8 * half;
        int res, q0sub;
        if (pat == 0) { res = 0; q0sub = s0 + 32 * tk; } else if (pat == 1) { res = tk >> 2; q0sub = s0 / 4 + 32 * (tk & 3); } else { res = tk; q0sub = s0 / 16; }
        const long qtok = rowbase + (long)dil * q0sub + res;
        a.qp = Z + ((size_t)h * T + qtok) * 64; a.qstride = (long)dil * 64; a.kp = Z + ((size_t)(8 + h) * T + rowbase + res) * 64; a.vp = a.kp + (size_t)8 * T * 64; a.kvstride = (long)dil * 64;
        a.kfirst = q0sub - 128; a.jmin = q0sub >= 128 ? 0 : (128 - q0sub) / 32; a.jmax = 4;
        a.op = PO + ((size_t)pat * T + qtok) * 512 + 64 * h; a.ostride = (long)dil * 512; a.lp = LP + ((size_t)pat * T + qtok) * 8 + h; a.lstride = dil * 8; }
    return a;
}
__device__ __forceinline__ void kload4(bf16x8 (&k)[4], const bf16* p) {
    asm volatile("global_load_dwordx4 %0, %4, off\n\tglobal_load_dwordx4 %1, %4, off offset:32\n\tglobal_load_dwordx4 %2, %4, off offset:64\n\tglobal_load_dwordx4 %3, %4, off offset:96"
                 : "=&v"(k[0]), "=&v"(k[1]), "=&v"(k[2]), "=&v"(k[3]) : "v"(p) : "memory");
}
__device__ __forceinline__ void glds16(const void* gsrc, unsigned lds_dst) { unsigned keep;
    asm volatile("s_mov_b32 %0, m0\n\ts_mov_b32 m0, %2\n\ts_nop 0\n\tglobal_load_lds_dwordx4 %1, off\n\ts_mov_b32 m0, %0" : "=&s"(keep) : "v"(gsrc), "s"(lds_dst) : "memory"); }
__device__ __forceinline__ void p2_attention(Frame& F) {
    const bf16* Z = (const bf16*)(F.wsh + WS_Z); bf16* MIX = (bf16*)(F.wsh + WS_MIX);
    const bf16* PO = (const bf16*)(F.wsh + WS_PO); const float* LP = (const float*)(F.ws + WS_LP);
    LAS unsigned char* wl = F.lds + F.wave * 16384; LAS float* wsf = (LAS float*)(F.lds + WSCR_OFF + F.wave * 256);
    const unsigned wl0 = (unsigned)(uintptr_t)wl;
    const int lane = F.lane, r32 = lane & 31, hi = lane >> 5;
    const int vlane = ((lane >> 4) & 1) * 32 + (lane & 3) * 8 + (4 * hi + ((lane & 15) >> 2)) * 64;
    for (int cid = F.vcu; cid < 256; cid += F.G) {
        const int b = cid >> 6, h = 4 * ((cid >> 5) & 1) + (cid & 3), ci = (cid >> 2) & 7;
        const int s0 = ci * 512; const long rowbase = (long)b * SEQ;
        { LAS unsigned char* pl = F.lds; const int g = h >> 1;
          { const bf16* up = Z + ((size_t)(24 + (h >> 1)) * T + rowbase + s0 + F.tid) * 64 + 32 * (h & 1); u32x4 v[4];
#pragma unroll
            for (int q = 0; q < 4; ++q) v[q] = *(const u32x4*)(up + 8 * q);
            u32x4 hv[4];
            if (F.tid < 15) {
#pragma unroll
                for (int q = 0; q < 4; ++q) hv[q] = (s0 > 0) ? *(const u32x4*)(up - 15L * 64 + 8 * q) : (u32x4){0u, 0u, 0u, 0u}; }
#pragma unroll
            for (int q = 0; q < 4; ++q) *(LAS u32x4*)(pl + (F.tid + 15) * 80 + 16 * q) = v[q];
            if (F.tid < 15) {
#pragma unroll
                for (int q = 0; q < 4; ++q) *(LAS u32x4*)(pl + F.tid * 80 + 16 * q) = hv[q]; } }
          LDS_WAIT(); __syncthreads();
          const int s = s0 + F.tid, w = 2 << g, cnt = (s + 1 < w) ? s + 1 : w;
          float a[32];
#pragma unroll
          for (int c = 0; c < 32; ++c) a[c] = 0.f;
          u32x4 us[4];
          const LAS unsigned char* pr = pl + (F.tid + 15) * 80;
#pragma unroll
          for (int q = 0; q < 4; ++q) us[q] = *(const LAS u32x4*)(pr + 16 * q);
#pragma unroll 2
          for (int r = 0; r < w; ++r) {
#pragma unroll
              for (int q = 0; q < 4; ++q) { const u32x4 v = *(const LAS u32x4*)(pr - r * 80 + 16 * q);
                  a[8 * q + 0] += bflo(v.x); a[8 * q + 1] += bfhi(v.x); a[8 * q + 2] += bflo(v.y); a[8 * q + 3] += bfhi(v.y);
                  a[8 * q + 4] += bflo(v.z); a[8 * q + 5] += bfhi(v.z); a[8 * q + 6] += bflo(v.w); a[8 * q + 7] += bfhi(v.w); } }
          const float inv = 1.0f / (float)cnt;
          bf16* op = MIX + (rowbase + s) * DM + 512 + 32 * h;
#pragma unroll
          for (int q = 0; q < 4; ++q) { u32x4 w4;
              w4.x = pk2(a[8 * q + 0] * inv - bflo(us[q].x), a[8 * q + 1] * inv - bfhi(us[q].x)); w4.y = pk2(a[8 * q + 2] * inv - bflo(us[q].y), a[8 * q + 3] * inv - bfhi(us[q].y));
              w4.z = pk2(a[8 * q + 4] * inv - bflo(us[q].z), a[8 * q + 5] * inv - bfhi(us[q].z)); w4.w = pk2(a[8 * q + 6] * inv - bflo(us[q].w), a[8 * q + 7] * inv - bfhi(us[q].w));
              *(u32x4*)(op + 8 * q) = w4; }
          LDS_WAIT(); __syncthreads(); }
        VM_WAIT();
        ATask ia = p2_make_task(F, 0, b, ci, h), ca = ia; int it = 0, ij = ia.jmin, ct = 0, cj = ia.jmin;
        bf16x8 kA[4], kB[4], kC[4], qr[4];
        const LAS unsigned char* qb = wl + 12288;
#define P2_QDMA(A) do { const bf16* qs_ = (A).qp + (long)(lane >> 3) * (A).qstride + (lane & 7) * 8; \
            _Pragma("unroll") for (int i_ = 0; i_ < 4; ++i_) glds16(qs_ + (long)(8 * i_) * (A).qstride, (unsigned)__builtin_amdgcn_readfirstlane(wl0 + 12288 + i_ * 1024)); } while (0)
#define P2_QREAD() do { _Pragma("unroll") for (int d0 = 0; d0 < 4; ++d0) qr[d0] = *(const LAS bf16x8*)(qb + r32 * 128 + d0 * 32 + hi * 16); LDS_WAIT(); asm volatile("" ::: "memory"); } while (0)
        P2_QDMA(ca);
        asm volatile("s_waitcnt vmcnt(0)" ::: "memory");
        P2_QREAD();
        { const ATask na = p2_make_task(F, 1, b, ci, h); P2_QDMA(na); }
#define P2_ISSUE(KS, slot) do { const long tb_ = (long)(ia.kfirst + 32 * ij) * ia.kvstride; \
            kload4(KS, ia.kp + tb_ + (long)r32 * ia.kvstride + 8 * hi); \
            const bf16* vt_ = ia.vp + tb_ + (long)(lane >> 2) * ia.kvstride + (lane & 3) * 8; \
            _Pragma("unroll") for (int i_ = 0; i_ < 4; ++i_) glds16(vt_ + (long)(i_ & 1) * 16 * ia.kvstride + (i_ >> 1) * 32, (unsigned)__builtin_amdgcn_readfirstlane(wl0 + (slot) * 4096 + i_ * 1024)); \
            if (ij < ia.jmax) ++ij; else if (it < 6) { ++it; ia = p2_make_task(F, it, b, ci, h); ij = ia.jmin; } } while (0)
        P2_ISSUE(kA, 0); P2_ISSUE(kB, 1);
        f32x16 o[2]; float lacc = 0.f;
#pragma unroll
        for (int r = 0; r < 16; ++r) { o[0][r] = 0.f; o[1][r] = 0.f; }
        bool done = false;
#define P2_STEP(KC, KI, slotc, sloti) do { \
            P2_ISSUE(KI, sloti); \
            asm volatile("s_waitcnt vmcnt(16) ; KSET %0 %1 %2 %3" : "+v"(KC[0]), "+v"(KC[1]), "+v"(KC[2]), "+v"(KC[3]) :: "memory"); \
            __builtin_amdgcn_sched_barrier(0); \
              \
            const LAS unsigned char* vb = wl + (slotc) * 4096; \
            bf16x8 vf[2][2]; \
            _Pragma("unroll") for (int d0 = 0; d0 < 2; ++d0) { \
                _Pragma("unroll") for (int ks = 0; ks < 2; ++ks) { \
                    const LAS unsigned char* vp_ = vb + (d0 * 2 + ks) * 1024 + vlane; \
                    const s16x4 lo = __builtin_bit_cast(s16x4, __builtin_amdgcn_ds_read_tr16_b64_v4i16((LAS s16x4*)vp_)); \
                    const s16x4 hh = __builtin_bit_cast(s16x4, __builtin_amdgcn_ds_read_tr16_b64_v4i16((LAS s16x4*)(vp_ + 512))); \
                    vf[d0][ks] = (bf16x8){lo[0], lo[1], lo[2], lo[3], hh[0], hh[1], hh[2], hh[3]}; } } \
            __builtin_amdgcn_sched_barrier(0); \
            f32x16 p; \
            _Pragma("unroll") for (int r = 0; r < 16; ++r) p[r] = 0.f; \
            _Pragma("unroll") for (int d0 = 0; d0 < 4; ++d0) p = __builtin_amdgcn_mfma_f32_32x32x16_bf16(KC[d0], qr[d0], p, 0, 0, 0); \
            const int mm = (ct > 0) ? (cj == 0 ? 1 : (cj == 4 ? 2 : 0)) : 0; \
            _Pragma("unroll") for (int r = 0; r < 16; ++r) p[r] = __builtin_amdgcn_exp2f(p[r]); \
            if (mm != 0) { const int klo = (mm == 1) ? r32 : -1, khi = (mm == 2) ? r32 : 64; \
                _Pragma("unroll") for (int r = 0; r < 16; ++r) { const int kj = crow(r, hi); p[r] = (kj >= klo && kj <= khi) ? p[r] : 0.f; } } \
            lacc += (((p[0] + p[1]) + (p[2] + p[3])) + ((p[4] + p[5]) + (p[6] + p[7]))) + (((p[8] + p[9]) + (p[10] + p[11])) + ((p[12] + p[13]) + (p[14] + p[15]))); \
            u32x4 pw0, pw1; \
            pw0.x = pk2(p[0], p[1]); pw0.y = pk2(p[2], p[3]); pw0.z = pk2(p[4], p[5]); pw0.w = pk2(p[6], p[7]); \
            pw1.x = pk2(p[8], p[9]); pw1.y = pk2(p[10], p[11]); pw1.z = pk2(p[12], p[13]); pw1.w = pk2(p[14], p[15]); \
            const bf16x8 pa0 = __builtin_bit_cast(bf16x8, pw0), pa1 = __builtin_bit_cast(bf16x8, pw1); \
            _Pragma("unroll") for (int d0 = 0; d0 < 2; ++d0) { \
                _Pragma("unroll") for (int ks = 0; ks < 2; ++ks) o[d0] = __builtin_amdgcn_mfma_f32_32x32x16_bf16(ks ? pa1 : pa0, vf[d0][ks], o[d0], 0, 0, 0); } \
            asm volatile("" ::: "memory"); \
            if (cj == ca.jmax) { \
                LAS bf16* stg = (LAS bf16*)(wl + (slotc) * 4096);            \
                const float l = lacc + __shfl_xor(lacc, 32); \
                if (hi == 0) wsf[r32] = 1.0f / l; \
                LDS_WAIT(); asm volatile("" ::: "memory"); \
                _Pragma("unroll") for (int r = 0; r < 16; ++r) { const int qq = crow(r, hi); const float iv = wsf[qq]; \
                    _Pragma("unroll") for (int d0 = 0; d0 < 2; ++d0) stg[qq * 64 + 32 * d0 + r32] = (bf16)f2bf(o[d0][r] * iv); } \
                LDS_WAIT(); asm volatile("" ::: "memory"); \
                u32x4 ov[4]; \
                _Pragma("unroll") for (int i_ = 0; i_ < 4; ++i_) ov[i_] = *(const LAS u32x4*)(stg + (i_ * 8 + (lane >> 3)) * 64 + (lane & 7) * 8); \
                LDS_WAIT(); asm volatile("" ::: "memory"); \
                if (ct < 6) { asm volatile("s_waitcnt vmcnt(8)" ::: "memory");     \
                    P2_QREAD(); \
                    if (ct < 5) { const ATask na = p2_make_task(F, ct + 2, b, ci, h); P2_QDMA(na); } } \
                if (hi == 0 && ca.lp) ca.lp[(long)r32 * ca.lstride] = l; \
                _Pragma("unroll") for (int i_ = 0; i_ < 4; ++i_) *(u32x4*)(ca.op + (long)(i_ * 8 + (lane >> 3)) * ca.ostride + (lane & 7) * 8) = ov[i_]; \
                if (ct == 6) done = true; \
                else { ++ct; ca = p2_make_task(F, ct, b, ci, h); cj = ca.jmin; \
                    _Pragma("unroll") for (int r = 0; r < 16; ++r) { o[0][r] = 0.f; o[1][r] = 0.f; } lacc = 0.f; } \
            } else ++cj; } while (0)
        for (;;) {
            P2_STEP(kA, kC, 0, 2); if (done) break;
            P2_STEP(kB, kA, 1, 0); if (done) break;
            P2_STEP(kC, kB, 2, 1); if (done) break;
        }
#undef P2_STEP
#undef P2_ISSUE
#undef P2_QDMA
#undef P2_QREAD
        asm volatile("s_waitcnt vmcnt(0) ; KSETS %0 %1 %2" : "+v"(kA[0]), "+v"(kB[0]), "+v"(kC[0]) :: "memory");
        asm volatile("" : "+v"(kA[1]), "+v"(kA[2]), "+v"(kA[3]), "+v"(kB[1]), "+v"(kB[2]), "+v"(kB[3]), "+v"(kC[1]), "+v"(kC[2]), "+v"(kC[3]));
        __syncthreads();
        { const int c = F.lane & 7;
#pragma unroll 2
          for (int itn = 0; itn < 8; ++itn) {
              const long row = rowbase + s0 + F.wave * 64 + itn * 8 + (F.lane >> 3);
              const float l0 = LP[((size_t)0 * T + row) * 8 + h], l1 = LP[((size_t)1 * T + row) * 8 + h], l2 = LP[((size_t)2 * T + row) * 8 + h];
              const float il = 1.0f / (l0 + l1 + l2), w0 = l0 * il, w1 = l1 * il, w2 = l2 * il;
              const u32x4 a = *(const u32x4*)(PO + ((size_t)0 * T + row) * 512 + 64 * h + 8 * c), bb = *(const u32x4*)(PO + ((size_t)1 * T + row) * 512 + 64 * h + 8 * c),
                          cc = *(const u32x4*)(PO + ((size_t)2 * T + row) * 512 + 64 * h + 8 * c);
              u32x4 w;
              w.x = pk2(w0 * bflo(a.x) + w1 * bflo(bb.x) + w2 * bflo(cc.x), w0 * bfhi(a.x) + w1 * bfhi(bb.x) + w2 * bfhi(cc.x));
              w.y = pk2(w0 * bflo(a.y) + w1 * bflo(bb.y) + w2 * bflo(cc.y), w0 * bfhi(a.y) + w1 * bfhi(bb.y) + w2 * bfhi(cc.y));
              w.z = pk2(w0 * bflo(a.z) + w1 * bflo(bb.z) + w2 * bflo(cc.z), w0 * bfhi(a.z) + w1 * bfhi(bb.z) + w2 * bfhi(cc.z));
              w.w = pk2(w0 * bflo(a.w) + w1 * bflo(bb.w) + w2 * bflo(cc.w), w0 * bfhi(a.w) + w1 * bfhi(bb.w) + w2 * bfhi(cc.w));
              *(u32x4*)(MIX + row * DM + 64 * h + 8 * c) = w; } }
        VM_WAIT(); __syncthreads();
    }
}

__device__ __forceinline__ void p4_router(Frame& F) {
    const bf16* XG = (const bf16*)(F.wsh + WS_XG); const bf16* RT = (const bf16*)(F.ws + WS_RT); const float* SSQ = (const float*)(F.ws + WS_SSQ);
    unsigned* TOKPOS = (unsigned*)(F.ws + WS_TOKPOS); unsigned* ROWTOK = (unsigned*)(F.ws + WS_ROWTOK); float* ROWGATE = (float*)(F.ws + WS_ROWGATE);
    unsigned* CNT = (unsigned*)(F.ws + WS_CTL) + CW_CNT; float* ROWRSTD = (float*)(F.ws + WS_ROWRSTD);
    const float* bg = F.in[15]; const float* br = F.in[17]; unsigned char* X1Q = F.wsh + WS_X1Q;
    LAS float* PL = (LAS float*)F.lds;
    LAS unsigned* hist = (LAS unsigned*)(F.lds + 100352); LAS unsigned* hbase = hist + 64;
    const int lane = F.lane, r32 = lane & 31, hi = lane >> 5, tb = F.wave >> 2, kq = F.wave & 3;
    if (F.vcu == 0 && F.tid < 256) ((unsigned*)(X1Q + (size_t)T * DM))[F.tid] = 0u;
    for (int tg = F.vcu; tg < T / 64; tg += F.G) {
        f32x16 acc[3];
#pragma unroll
        for (int nb = 0; nb < 3; ++nb)
#pragma unroll
            for (int r = 0; r < 16; ++r) acc[nb][r] = 0.f;
        LAS unsigned char* st = F.lds + F.wave * 16384;
        { const bf16* x0 = XG + (size_t)(tg * 64 + tb * 32) * DM + 256 * kq; const unsigned sb = (unsigned)(uintptr_t)st;
#pragma unroll
          for (int i = 0; i < 16; ++i) { const int r = 2 * i + hi; glds16(x0 + (size_t)r * DM + ((r32 ^ r) & 31) * 8, sb + i * 1024); } }
        const bf16* bp = RT + (size_t)(kq * 16 * 3 * 64 + lane) * 8;
        bf16x8 b0[4][3];
#pragma unroll
        for (int s = 0; s < 4; ++s)
#pragma unroll
            for (int nb = 0; nb < 3; ++nb) b0[s][nb] = *(const bf16x8*)(bp + (size_t)((s * 3 + nb) * 64) * 8);
        float ssp = 0.f;
        if (F.tid < 64) {
#pragma unroll
            for (int i = 0; i < 4; ++i) { const f32x4 v = *(const f32x4*)(SSQ + (size_t)(tg * 64 + F.tid) * 16 + 4 * i); ssp += (v[0] + v[1]) + (v[2] + v[3]); } }
        VM_WAIT();
#pragma unroll
        for (int j = 0; j < 8; ++j) { const int r = 4 * j + (lane >> 4), q = lane & 15;
            const u32x4 c0 = *(const LAS u32x4*)(st + r * 512 + (((2 * q) ^ r) & 31) * 16), c1 = *(const LAS u32x4*)(st + r * 512 + (((2 * q + 1) ^ r) & 31) * 16);
            u32x4 o; o.x = pk4f8(bflo(c0.x), bfhi(c0.x), bflo(c0.y), bfhi(c0.y)); o.y = pk4f8(bflo(c0.z), bfhi(c0.z), bflo(c0.w), bfhi(c0.w));
            o.z = pk4f8(bflo(c1.x), bfhi(c1.x), bflo(c1.y), bfhi(c1.y)); o.w = pk4f8(bflo(c1.z), bfhi(c1.z), bflo(c1.w), bfhi(c1.w));
            *(u32x4*)(X1Q + (size_t)(tg * 64 + tb * 32 + r) * DM + 256 * kq + 16 * q) = o; }
#pragma unroll
        for (int s = 0; s < 4; ++s) { const bf16x8 a = *(const LAS bf16x8*)(st + r32 * 512 + (((2 * s + hi) ^ r32) & 31) * 16);
#pragma unroll
            for (int nb = 0; nb < 3; ++nb) acc[nb] = __builtin_amdgcn_mfma_f32_32x32x16_bf16(b0[s][nb], a, acc[nb], 0, 0, 0); }
#pragma unroll 4
        for (int s = 4; s < 16; ++s) { const bf16x8 a = *(const LAS bf16x8*)(st + r32 * 512 + (((2 * s + hi) ^ r32) & 31) * 16);
#pragma unroll
            for (int nb = 0; nb < 3; ++nb) { const bf16x8 bb = *(const bf16x8*)(bp + (size_t)((s * 3 + nb) * 64) * 8); acc[nb] = __builtin_amdgcn_mfma_f32_32x32x16_bf16(bb, a, acc[nb], 0, 0, 0); } }
        LDS_WAIT(); __syncthreads();
        LAS float* pw = PL + (size_t)(F.wave * 32 + r32) * 97;
#pragma unroll
        for (int nb = 0; nb < 3; ++nb)
#pragma unroll
            for (int r = 0; r < 16; ++r) pw[32 * nb + crow(r, hi)] = acc[nb][r];
        if (F.tid < 64) hist[F.tid] = 0u;
        LDS_WAIT(); __syncthreads();
        int e1 = 0, e2 = 0; unsigned k1 = 0, k2 = 0; float g1 = 0.f, g2 = 0.f, rstdv = 0.f;
        if (F.tid < 64) {
            const int t2 = F.tid >> 5, rr = F.tid & 31, tk = tg * 64 + F.tid;
            const LAS float* p0 = PL + (size_t)((t2 * 4) * 32 + rr) * 97;
#define LOGIT(n) (p0[(n)] + p0[32 * 97 + (n)] + p0[64 * 97 + (n)] + p0[96 * 97 + (n)])
            const float ss = ssp;
            const float rstd = 1.0f / sqrtf(ss * (1.f / DM) + EPS);
            float lg[8]; int g = 0; float gm = -3.0e38f;
#pragma unroll
            for (int j = 0; j < 8; ++j) { lg[j] = rstd * LOGIT(j) + bg[j]; if (lg[j] > gm) { gm = lg[j]; g = j; } }
            float den = 0.f;
#pragma unroll
            for (int j = 0; j < 8; ++j) den += __expf(lg[j] - gm);
            const float pg = 1.0f / den;
            float le[8]; int i1 = 0; float v1 = -3.0e38f;
#pragma unroll
            for (int j = 0; j < 8; ++j) { le[j] = rstd * LOGIT(8 + 8 * g + j) + br[8 * g + j]; if (le[j] > v1) { v1 = le[j]; i1 = j; } }
            int i2 = 0; float v2 = -3.0e38f;
#pragma unroll
            for (int j = 0; j < 8; ++j) { if (j != i1 && le[j] > v2) { v2 = le[j]; i2 = j; } }
#undef LOGIT
            const float p1 = 1.0f / (1.0f + __expf(v2 - v1)), p2 = 1.0f - p1;
            rstdv = rstd;
            e1 = 8 * g + i1; e2 = 8 * g + i2; g1 = pg * p1; g2 = pg * p2;
            k1 = __hip_atomic_fetch_add(&hist[e1], 1u, __ATOMIC_RELAXED, __HIP_MEMORY_SCOPE_WORKGROUP); k2 = __hip_atomic_fetch_add(&hist[e2], 1u, __ATOMIC_RELAXED, __HIP_MEMORY_SCOPE_WORKGROUP);
        }
        LDS_WAIT(); __syncthreads();
        if (F.tid < 64) { const unsigned n = hist[F.tid]; hbase[F.tid] = n ? atomicAdd(&CNT[F.tid * CNT_STRIDE], n) : 0u; }
        LDS_WAIT(); __syncthreads();
        if (F.tid < 64) { const int tk = tg * 64 + F.tid;
            const unsigned sl1 = (unsigned)e1 * CAP + hbase[e1] + k1, sl2 = (unsigned)e2 * CAP + hbase[e2] + k2;
            ROWTOK[sl1] = (unsigned)tk; ROWGATE[sl1] = g1; ROWRSTD[sl1] = rstdv; ROWTOK[sl2] = (unsigned)tk; ROWGATE[sl2] = g2; ROWRSTD[sl2] = rstdv;
            TOKPOS[2 * tk] = sl1; TOKPOS[2 * tk + 1] = sl2;
        }
        __syncthreads();
    }
}

__device__ __forceinline__ void p7_combine(Frame& F, const LAS int* tab) {
    const unsigned* TOKPOS = (const unsigned*)(F.ws + WS_TOKPOS); const bf16* YB = (const bf16*)(F.wsh + WS_YB);
    const int gw = F.vcu * 8 + F.wave, NGW = F.G * 8;
    for (int m = gw; m < T; m += NGW) {
        const unsigned s1 = TOKPOS[2 * m], s2 = TOKPOS[2 * m + 1];
        const size_t h1 = (size_t)tab[259 + (s1 >> 15)] + (s1 & 32767u), h2 = (size_t)tab[259 + (s2 >> 15)] + (s2 & 32767u);
        const GAS u32x2* x1 = (const GAS u32x2*)((const bf16*)(F.wsh + WS_XG) + (size_t)m * DM) + F.lane; GAS f32x4* od = (GAS f32x4*)(F.out + (size_t)m * DM) + F.lane;
        const GAS u32x2* y1 = (const GAS u32x2*)(YB + h1 * DM) + F.lane; const GAS u32x2* y2 = (const GAS u32x2*)(YB + h2 * DM) + F.lane;
#pragma unroll
        for (int j = 0; j < 4; ++j) { const u32x2 xx = __builtin_nontemporal_load(&x1[64 * j]), a = __builtin_nontemporal_load(&y1[64 * j]), b = __builtin_nontemporal_load(&y2[64 * j]); f32x4 v;
            v[0] = bflo(xx.x) + (bflo(a.x) + bflo(b.x)); v[1] = bfhi(xx.x) + (bfhi(a.x) + bfhi(b.x)); v[2] = bflo(xx.y) + (bflo(a.y) + bflo(b.y)); v[3] = bfhi(xx.y) + (bfhi(a.y) + bfhi(b.y)); __builtin_nontemporal_store(v, &od[64 * j]); }
    }
}

__global__ void __launch_bounds__(512, 2) fwd_kernel(Args args) {
    extern __shared__ __attribute__((aligned(16))) unsigned char lds[];
    Frame F;
    F.lds = (LAS unsigned char*)lds; F.tid = threadIdx.x; F.lane = F.tid & 63; F.wave = __builtin_amdgcn_readfirstlane(F.tid >> 6);
    F.G = gridDim.x; { const int bx = blockIdx.x; F.vcu = (F.G % 8 == 0) ? (bx % 8) * (F.G / 8) + bx / 8 : bx; }
#pragma unroll
    for (int i = 0; i < 21; ++i) F.in[i] = args.in[i];
    F.out = args.out; F.ws = args.ws; F.wsh = args.wsh;
    volatile LAS unsigned* MISC = (volatile LAS unsigned*)(F.lds + MISC_OFF);
    for (int u = F.tid; u < (LDS_BYTES - LDSCTL_OFF) / 4; u += 512) ((LAS unsigned*)(F.lds + LDSCTL_OFF))[u] = 0u;
    __syncthreads();
    unsigned* ctl = (unsigned*)(F.ws + WS_CTL);
    XcdBarrier bar = xcd_barrier_post(ctl + CW_BAR, MISC + 8);
    const int lo = args.ph_lo, hi = args.ph_hi;
#define IN(k) (lo <= (k) && (k) < hi)
#define SEAM(k) do { if (IN(k) && IN((k) + 1)) xcd_barrier(bar); } while (0)
    LAS int* tab = (LAS int*)(F.lds + TAB_OFF);

    if (IN(0)) { p0_prologue(F); }
    { const XbTicket t01 = xcd_barrier_arrive(bar); expert_convert<1>(F); LDS_WAIT(); xcd_barrier_wait(bar, t01); }
    if (IN(1)) {
        pg8::Gemm g{(const bf16*)(F.wsh + WS_XB), (const bf16*)(F.ws + WS_WIN), DM}; pg8::StaticOrder S; S.init(T, INW, F.G, (int)blockIdx.x);
        LAS float* gz = (LAS float*)(F.lds + GZ_OFF);
        if (F.tid < 192) gz[F.tid] = F.tid < 64 ? F.in[4][F.tid] * C2 : (F.tid < 128 ? F.in[5][F.tid - 64] : F.in[10][F.tid - 128] * C2);
        LDS_WAIT(); __syncthreads();
        pg8::EpiZ E{(bf16*)(F.wsh + WS_Z), (const float*)(F.ws + WS_RS), gz};
        pg8::gemm_phase<pg8::EpiZ, pg8::StaticOrder, false, false>(F.lds, g, S, E);
    }
    { const XbTicket t12 = xcd_barrier_arrive(bar); expert_convert<2>(F); LDS_WAIT(); xcd_barrier_wait(bar, t12); }
    if (IN(2)) { p2_attention(F); }
    { const XbTicket t23 = xcd_barrier_arrive(bar); expert_convert<3>(F); LDS_WAIT(); xcd_barrier_wait(bar, t23); }
    const bool split3 = (F.G == 256);
    if (IN(3) && (!split3 || ((blockIdx.x >> 3) & 1) == 0)) {
        const int bx = (int)blockIdx.x;
        pg8::Gemm g{(const bf16*)(F.wsh + WS_MIX), (const bf16*)(F.ws + WS_WOUT), DM}; pg8::StaticOrder S; S.init(T, DM, split3 ? 128 : F.G, split3 ? (bx & 7) + 8 * (bx >> 4) : bx); S.sp = split3;
        pg8::EpiX1 E{(const bf16*)(F.wsh + WS_XB), (bf16*)(F.wsh + WS_XG), (float*)(F.ws + WS_SSQ)};
        pg8::gemm_phase<pg8::EpiX1, pg8::StaticOrder, false, false>(F.lds, g, S, E);
    }
    if (split3) cv_w13_queue(F);
    const XbTicket t34 = xcd_barrier_arrive(bar);
    if (!split3) expert_convert<0>(F);
    LDS_WAIT();
    xcd_barrier_wait(bar, t34);
    p4_router(F);
    const XbTicket t45 = xcd_barrier_arrive(bar);
    expert_convert<4>(F);
    LDS_WAIT();
    xcd_barrier_wait(bar, t45);
    if (IN(5) || IN(6) || IN(7)) {
        if (F.tid < 64) { const int c = (int)__hip_atomic_load(ctl + CW_CNT + F.tid * CNT_STRIDE, RLX_AGENT); const int ntl = (c + 255) >> 8;
            const int lt = (ntl > 0 && c - (ntl - 1) * 256 <= 128) ? 1 : 0; int i0 = ntl, i1 = ntl - lt, i2 = lt, i3 = c;
#pragma unroll
            for (int o = 1; o < 64; o <<= 1) { const int v0 = __shfl_up(i0, o), v1 = __shfl_up(i1, o), v2 = __shfl_up(i2, o), v3 = __shfl_up(i3, o); if (F.lane >= o) { i0 += v0; i1 += v1; i2 += v2; i3 += v3; } }
            tab[F.tid] = c; tab[64 + F.tid + 1] = i0; tab[129 + F.tid + 1] = i1; tab[194 + F.tid + 1] = i2; tab[259 + F.tid + 1] = i3; if (F.tid == 0) { tab[64] = 0; tab[129] = 0; tab[194] = 0; tab[259] = 0; } }
        LDS_WAIT(); __syncthreads();
    }
    if (IN(5)) {
        pg8::Gemm g{(const bf16*)(F.wsh + WS_X1Q), (const bf16*)(F.wsh + WS_W13), DM / 2};
        pg8::GroupOrder S{tab, (const unsigned*)(F.ws + WS_ROWTOK), F.G, (int)blockIdx.x};
        pg8::EpiH E{F.wsh + WS_HMID, (const float*)(F.ws + WS_ROWRSTD)};
        pg8::gemm_phase<pg8::EpiH, pg8::GroupOrder, true, true>(F.lds, g, S, E);
    }
    SEAM(5);
    if (IN(6)) {
        pg8::Gemm g{(const bf16*)(F.wsh + WS_HMID), (const bf16*)(F.wsh + WS_W2), EH / 2};
        pg8::GroupOrder S{tab, (const unsigned*)(F.ws + WS_ROWTOK), F.G, (int)blockIdx.x};
        pg8::EpiY E{(bf16*)(F.wsh + WS_YB), (const float*)(F.ws + WS_ROWGATE), tab};
        pg8::gemm_phase<pg8::EpiY, pg8::GroupOrder, false, true>(F.lds, g, S, E);
    }
    SEAM(6);
    if (IN(7)) { p7_combine(F, tab); }
#undef IN
#undef SEAM
}

extern "C" void kernel_launch(void* const* d_in, const int* in_sizes, int n_in, void* d_out, int out_size, void* d_ws, size_t ws_size, hipStream_t stream) {
    static int grid = 0;
    if (grid == 0) {
        if (n_in != 21 || out_size != T * DM || ws_size < WS_END) { fprintf(stderr, "kernel_launch: unexpected shapes (n_in %d out %d ws %zu)\n", n_in, out_size, ws_size); grid = -1; return; }
        int dev = 0, cus = 0, per_cu = 0;
        if (hipGetDevice(&dev) != hipSuccess || hipDeviceGetAttribute(&cus, hipDeviceAttributeMultiprocessorCount, dev) != hipSuccess) { grid = -1; return; }
        if (hipFuncSetAttribute((const void*)fwd_kernel, hipFuncAttributeMaxDynamicSharedMemorySize, LDS_BYTES) != hipSuccess) { fprintf(stderr, "kernel_launch: hipFuncSetAttribute failed\n"); grid = -1; return; }
        if (hipOccupancyMaxActiveBlocksPerMultiprocessor(&per_cu, (const void*)fwd_kernel, 512, LDS_BYTES) != hipSuccess || per_cu < 1) { fprintf(stderr, "kernel_launch: occupancy query says %d\n", per_cu); }
        (void)hipGetLastError();
        grid = cus;
    }
    if (grid < 0) return;
    if (hipMemsetAsync((char*)d_ws + WS_CTL, 0, CTL_ZERO_BYTES, stream) != hipSuccess) return;
    Args a{};
    for (int i = 0; i < 21; ++i) a.in[i] = (const float*)d_in[i];
    a.out = (float*)d_out; a.ws = (unsigned char*)d_ws; a.wsh = (unsigned char*)d_ws + (((ws_size >> 20) << 20) - WS_END); a.ph_lo = 0; a.ph_hi = 8;
    hipLaunchKernelGGL(fwd_kernel, dim3(grid), dim3(512), LDS_BYTES, stream, a);
}
```
